# Optimizing an MI355X kernel written in HIP

```python
import math
import jax, jax.numpy as jnp
from jax import lax
import numpy as np


D_MODEL = 1024
BATCH = 8
SEQ = 4096
DEPTH = 4

CTX_LEN = 256
GRID_W = 64
EPS = 1e-6

DA_HEADS = 4
DA_WIDTH = D_MODEL // 2
DA_HEAD_DIM = DA_WIDTH // (2 * DA_HEADS)
ROPE_BASE = 10000.0
Q_BLOCK = 128

CM_GROUPS = 4
CM_WIDTH = D_MODEL // 4
CM_GROUP_DIM = CM_WIDTH // CM_GROUPS
CHUNK = 128

POOL_WINDOWS = (2, 4, 8, 16)
PL_WIDTH = D_MODEL // 4
PL_GROUP_DIM = PL_WIDTH // len(POOL_WINDOWS)

MIX_WIDTH = DA_WIDTH + CM_WIDTH + PL_WIDTH
IN_WIDTH = 3 * DA_WIDTH + 2 * CM_WIDTH + PL_WIDTH
D_FF = 4 * D_MODEL

kernel_name = 'hybrid_diffattn_gmlp_pool_dit_trunk'


def rmsnorm(x, g):
    xf = x.astype(jnp.float32)
    y = xf * lax.rsqrt(jnp.mean(xf * xf, axis=-1, keepdims=True) + EPS)
    return (y * g.astype(jnp.float32)).astype(x.dtype)


def modulation(cond, w_ada, b_ada):
    m = jax.nn.silu(cond) @ w_ada + b_ada
    return jnp.split(m, 6, axis=-1)


def modulate(h, shift, scale):
    return h * (1 + scale) + shift


def axial_rope_tables(n_tokens):
    n_rows = n_tokens // GRID_W
    row = jnp.repeat(jnp.arange(n_rows), GRID_W).astype(jnp.float32)
    col = jnp.tile(jnp.arange(GRID_W), n_rows).astype(jnp.float32)
    n_freq = DA_HEAD_DIM // 4
    inv = ROPE_BASE ** (-jnp.arange(n_freq, dtype=jnp.float32) / n_freq)
    ang = jnp.stack([row[:, None] * inv, col[:, None] * inv], axis=1)
    return jnp.cos(ang), jnp.sin(ang)


def apply_axial_rope(x, cos, sin):
    n_freq = x.shape[-1] // 4
    xs = x.astype(jnp.float32).reshape(x.shape[:-1] + (2, 2, n_freq))
    x1 = xs[..., 0, :]
    x2 = xs[..., 1, :]
    c = cos[None, :, None, None]
    s = sin[None, :, None, None]
    out = jnp.stack([x1 * c - x2 * s, x2 * c + x1 * s], axis=-2)
    return out.reshape(x.shape).astype(x.dtype)


def diff_attention(q, k, v, lam):
    scale = DA_HEAD_DIM ** -0.5
    s = jnp.einsum('bqhjd,bkhjd->bhjqk', q, k).astype(jnp.float32) * scale
    p = jax.nn.softmax(s, axis=-1)
    a = p[:, :, 0] - lam * p[:, :, 1]
    return jnp.einsum('bhqk,bkhe->bqhe', a.astype(v.dtype), v)


def latent_diff_attention(ql, kl, vl, kc, vc, lam):
    b, t, h, _, d = ql.shape
    k = jnp.concatenate([kc, kl], axis=1)
    v = jnp.concatenate([vc, vl], axis=1)
    nb = t // Q_BLOCK
    qb = jnp.moveaxis(ql.reshape(b, nb, Q_BLOCK, h, 2, d), 1, 0)
    out = lax.map(lambda qblk: diff_attention(qblk, k, v, lam), qb)
    return jnp.moveaxis(out, 0, 1).reshape(b, t, h, 2 * d)


def chunk_spatial_gating(u, v, g_v, w_s, b_s):
    b, t, _ = v.shape
    n = t // CHUNK
    vn = rmsnorm(v.reshape(b, t, CM_GROUPS, CM_GROUP_DIM), g_v.reshape(CM_GROUPS, CM_GROUP_DIM))
    vn = vn.reshape(b, n, CHUNK, CM_GROUPS, CM_GROUP_DIM)
    vm = jnp.einsum('gpq,bnqgc->bnpgc', w_s, vn) + b_s.T[:, :, None]
    return u * vm.reshape(b, t, CM_WIDTH)


def multiscale_pool(x, w_pool, s_pool):
    b, t, _ = x.shape
    xg = x.reshape(b, t, len(POOL_WINDOWS), PL_GROUP_DIM)
    pos = jnp.arange(t)
    outs = []
    for gi, w in enumerate(POOL_WINDOWS):
        xs = xg[:, :, gi].astype(jnp.float32)
        cs = jnp.concatenate([jnp.zeros_like(xs[:, :1]), jnp.cumsum(xs, axis=1)], axis=1)
        lo = jnp.clip(pos - w // 2, 0, t)
        hi = jnp.clip(pos + (w - w // 2), 0, t)
        mean = (cs[:, hi] - cs[:, lo]) / (hi - lo).astype(jnp.float32)[None, :, None]
        outs.append(mean - xs)
    d = jnp.stack(outs, axis=2).astype(x.dtype)
    y = jnp.einsum('btgc,gce->btge', d, w_pool).reshape(b, t, PL_WIDTH)
    return y * s_pool


def split_projection(h, w_in):
    z = h @ w_in
    b, t, _ = z.shape
    cuts = np.cumsum([DA_WIDTH, DA_WIDTH, DA_WIDTH, CM_WIDTH, CM_WIDTH])
    q, k, v, u, gv, p = jnp.split(z, [int(i) for i in cuts], axis=-1)
    q = q.reshape(b, t, DA_HEADS, 2, DA_HEAD_DIM)
    k = k.reshape(b, t, DA_HEADS, 2, DA_HEAD_DIM)
    v = v.reshape(b, t, DA_HEADS, 2 * DA_HEAD_DIM)
    return q, k, v, u, gv, p


def merge_heads(a, g_sub, lam_init, u, gv, p, g_v, w_s, b_s, w_pool, s_pool, w_out):
    b, t = a.shape[:2]
    a = (rmsnorm(a, g_sub) * (1 - lam_init)).reshape(b, t, DA_WIDTH)
    m_b = chunk_spatial_gating(u, gv, g_v, w_s, b_s)
    m_c = multiscale_pool(p, w_pool, s_pool)
    return jnp.concatenate([a, m_b, m_c], axis=-1) @ w_out


def sq_relu_mlp(h, w1, w2):
    return jnp.square(jax.nn.relu(h @ w1)) @ w2


def setup_inputs(seed: int = 0) -> dict:
    key = jax.random.key(seed)
    ks = jax.random.split(key, 24)
    f32 = jnp.float32
    nrm = lambda k, shape: jax.random.normal(k, shape, f32)
    L = DEPTH
    return {
        'x': nrm(ks[0], (BATCH, SEQ, D_MODEL)),
        'c': nrm(ks[1], (BATCH, D_MODEL)),
        'ctx': nrm(ks[2], (BATCH, CTX_LEN, D_MODEL)),
        'c_ctx': nrm(ks[3], (D_MODEL,)),
        'w_ada': nrm(ks[4], (L, D_MODEL, 6 * D_MODEL)) * (0.5 * D_MODEL ** -0.5),
        'b_ada': nrm(ks[5], (L, 6 * D_MODEL)) * 0.02,
        'g_norm_mix': 1.0 + 0.02 * nrm(ks[6], (L, D_MODEL)),
        'g_norm_mlp': 1.0 + 0.02 * nrm(ks[7], (L, D_MODEL)),
        'w_in': nrm(ks[8], (L, D_MODEL, IN_WIDTH)) * D_MODEL ** -0.5,
        'lam_q1': 0.1 * nrm(ks[9], (L, DA_HEAD_DIM)),
        'lam_k1': 0.1 * nrm(ks[10], (L, DA_HEAD_DIM)),
        'lam_q2': 0.1 * nrm(ks[11], (L, DA_HEAD_DIM)),
        'lam_k2': 0.1 * nrm(ks[12], (L, DA_HEAD_DIM)),
        'g_subln': 1.0 + 0.02 * nrm(ks[13], (L, 2 * DA_HEAD_DIM)),
        'g_vnorm': 1.0 + 0.02 * nrm(ks[14], (L, CM_WIDTH)),
        'w_spatial': nrm(ks[15], (L, CM_GROUPS, CHUNK, CHUNK)) * CHUNK ** -0.5,
        'b_spatial': 1.0 + 0.02 * nrm(ks[16], (L, CM_GROUPS, CHUNK)),
        'w_pool': nrm(ks[17], (L, len(POOL_WINDOWS), PL_GROUP_DIM, PL_GROUP_DIM)) * PL_GROUP_DIM ** -0.5,
        's_pool': 1.0 + 0.02 * nrm(ks[18], (L, PL_WIDTH)),
        'w_out': nrm(ks[19], (L, MIX_WIDTH, D_MODEL)) * MIX_WIDTH ** -0.5,
        'w1': nrm(ks[20], (L, D_MODEL, D_FF)) * D_MODEL ** -0.5,
        'w2': nrm(ks[21], (L, D_FF, D_MODEL)) * D_FF ** -0.5,
        'g_final': 1.0 + 0.02 * nrm(ks[22], (D_MODEL,)),
    }


def reference(x, c, ctx, c_ctx, w_ada, b_ada, g_norm_mix, g_norm_mlp, w_in,
              lam_q1, lam_k1, lam_q2, lam_k2, g_subln, g_vnorm, w_spatial, b_spatial,
              w_pool, s_pool, w_out, w1, w2, g_final):
    xl = x
    xc = ctx
    cos, sin = axial_rope_tables(xl.shape[1])
    for l in range(DEPTH):
        last = l == DEPTH - 1
        lam_init = 0.8 - 0.6 * math.exp(-0.3 * l)
        lam = (jnp.exp(jnp.sum(lam_q1[l].astype(jnp.float32) * lam_k1[l].astype(jnp.float32)))
               - jnp.exp(jnp.sum(lam_q2[l].astype(jnp.float32) * lam_k2[l].astype(jnp.float32)))
               + lam_init)
        sh1, sc1, gt1, sh2, sc2, gt2 = [m[:, None, :] for m in modulation(c, w_ada[l], b_ada[l])]
        csh1, csc1, cgt1, csh2, csc2, cgt2 = modulation(c_ctx, w_ada[l], b_ada[l])

        hl = modulate(rmsnorm(xl, g_norm_mix[l]), sh1, sc1)
        hc = modulate(rmsnorm(xc, g_norm_mix[l]), csh1, csc1)
        ql, kl, vl, ul, gvl, pl = split_projection(hl, w_in[l])
        qc, kc, vc, uc, gvc, pc = split_projection(hc, w_in[l])
        ql = apply_axial_rope(ql, cos, sin)
        kl = apply_axial_rope(kl, cos, sin)
        al = latent_diff_attention(ql, kl, vl, kc, vc, lam)
        mix_l = merge_heads(al, g_subln[l], lam_init, ul, gvl, pl, g_vnorm[l], w_spatial[l],
                            b_spatial[l], w_pool[l], s_pool[l], w_out[l])
        xl = xl + gt1 * mix_l
        if not last:
            ac = diff_attention(qc, kc, vc, lam)
            mix_c = merge_heads(ac, g_subln[l], lam_init, uc, gvc, pc, g_vnorm[l], w_spatial[l],
                                b_spatial[l], w_pool[l], s_pool[l], w_out[l])
            xc = xc + cgt1 * mix_c

        hl = modulate(rmsnorm(xl, g_norm_mlp[l]), sh2, sc2)
        xl = xl + gt2 * sq_relu_mlp(hl, w1[l], w2[l])
        if not last:
            hc = modulate(rmsnorm(xc, g_norm_mlp[l]), csh2, csc2)
            xc = xc + cgt2 * sq_relu_mlp(hc, w1[l], w2[l])
    return rmsnorm(xl, g_final)
```

```cpp
#include <hip/hip_runtime.h>
#include <hip/hip_cooperative_groups.h>
#include <cstdio>
#include <cstdint>
namespace cg = cooperative_groups;
__device__ __forceinline__ int opaque_tid() { int t = threadIdx.x; asm volatile("" : "+v"(t)); return t; }
namespace pg8 {
#define PG8_LAS __attribute__((address_space(3)))
typedef unsigned short bf16_t;
typedef short bf16x8 __attribute__((ext_vector_type(8)));
typedef float f32x4 __attribute__((ext_vector_type(4)));
typedef unsigned u32x4 __attribute__((ext_vector_type(4)));
constexpr int BM = 256, BK = 64, HALF = 128, HTB = HALF * BK * 2  , STAGE_BYTES = 8 * HTB, NXCD = 8, WGM = 8;

__host__ __device__ __forceinline__ int lds_byte(int r, int c) { const int st = (r >> 4) * 2 + (c >> 5), rr = r & 15, cc = c & 31, ob = rr * 64 + cc * 2; return st * 1024 + (ob ^ (((ob >> 9) & 1) << 5)); }
__host__ __device__ __forceinline__ void stage_rc(int b, int& R, int& C) { const int st = b / 1024, sb = b % 1024, swz = sb ^ (((sb >> 9) & 1) << 5); R = (st >> 1) * 16 + swz / 64; C = (st & 1) * 32 + (swz % 64) / 2; }
__host__ __device__ __forceinline__ int perm32(int rho) { const int n = rho >> 4, i = rho & 15; return 8 * (i >> 2) + 4 * n + (i & 3); }

struct Unit { int pm, pn; };
struct Gemm { const bf16_t* A; const bf16_t* Bt; int M, N, K, ld; };

struct StaticOrder {
    int nM, nN, nwg, G, c;
    __host__ __device__ void init(int M, int N, int G_, int c_) { nM = M / BM; nN = N / BM; nwg = nM * nN; G = G_; c = c_; }
    __host__ __device__ bool next(int i, Unit& u) const {
        const long L = (long)i * G + c; if (L >= nwg) return false;
        int wgid = (int)L; { const int q = nwg / NXCD, r = nwg % NXCD, xcd = wgid % NXCD, off = wgid / NXCD; wgid = (xcd < r ? xcd * (q + 1) : r * (q + 1) + (xcd - r) * q) + off; }
        const int nig = WGM * nN, gid = wgid / nig, fm = gid * WGM, gsz = (nM - fm) < WGM ? (nM - fm) : WGM;
        u.pm = fm + ((wgid % nig) % gsz); u.pn = (wgid % nig) / gsz; return true;
    }
    __device__ __forceinline__ void a_ready(const Unit&) const {}
    __device__ __forceinline__ void done(const Unit&) const {}
};

__device__ __forceinline__ unsigned cvt_pk_bf16(float lo, float hi) { unsigned r; asm volatile("v_cvt_pk_bf16_f32 %0, %1, %2" : "=v"(r) : "v"(lo), "v"(hi)); return r; }
typedef float f32x2 __attribute__((ext_vector_type(2)));
__device__ __forceinline__ f32x2 gelu_pk(f32x2 v) {
    const f32x2 av = __builtin_elementwise_abs(v), d = av * 0.2316418882f + 1.0f;
    f32x2 t; t.x = __builtin_amdgcn_rcpf(d.x); t.y = __builtin_amdgcn_rcpf(d.y);
    f32x2 q = t * 0.5307027145f + (-0.7265760135f); q = q * t + 0.7107068705f; q = q * t + (-0.142248368f); q = q * t + 0.127414796f; q = q * t;
    const f32x2 s = (v * v) * (-0.72134752044f);
    f32x2 e; e.x = __builtin_amdgcn_exp2f(s.x); e.y = __builtin_amdgcn_exp2f(s.y);
    const f32x2 m = v * (q * e), r = v - m;
    f32x2 o; o.x = v.x < 0.f ? m.x : r.x; o.y = v.y < 0.f ? m.y : r.y; return o;
}

template <int ACT  > struct EpiBf16 {
    static constexpr bool PERM = true, AFTER_DRAIN = false; static_assert(ACT == 0 || ACT == 1, "EpiBf16: ACT is 0 (none) or 1 (gelu_pk)");
    bf16_t* O; int ldc; const float* bias; int split_cols; size_t split_stride; float scale0;
    __device__ __forceinline__ void operator()(const f32x4 (&acc)[2][2][4][2], const Unit& u, int wr, int wc, int fr, int fq) const {
        const int row0 = u.pm * BM + wr * 64 + fr; int colt = u.pn * BM; bf16_t* base = O;
        float sc = 1.f; if (split_cols) { const int t = colt / split_cols; base += (size_t)t * split_stride; colt -= t * split_cols; if (t == 0) sc = scale0; }
        const int col0 = colt + wc * 32 + 8 * fq, bcol0 = u.pn * BM + wc * 32 + 8 * fq;
        f32x4 bv[2][2];
#pragma unroll
        for (int bj = 0; bj < 2; ++bj)
#pragma unroll
            for (int n = 0; n < 2; ++n) bv[bj][n] = bias ? *(const f32x4*)(bias + bcol0 + bj * HALF + 4 * n) : (f32x4){0.f, 0.f, 0.f, 0.f};
#pragma unroll
        for (int ai = 0; ai < 2; ++ai)
#pragma unroll
            for (int m = 0; m < 4; ++m) { bf16_t* rowp = base + (size_t)(row0 + ai * HALF + m * 16) * ldc + col0;
#pragma unroll
                for (int bj = 0; bj < 2; ++bj) { f32x4 v0 = acc[ai][bj][m][0] + bv[bj][0], v1 = acc[ai][bj][m][1] + bv[bj][1];
                    if (ACT == 1) { f32x2 a = gelu_pk((f32x2){v0[0], v0[1]}), b = gelu_pk((f32x2){v0[2], v0[3]}), c = gelu_pk((f32x2){v1[0], v1[1]}), d = gelu_pk((f32x2){v1[2], v1[3]});
                        v0 = (f32x4){a.x, a.y, b.x, b.y}; v1 = (f32x4){c.x, c.y, d.x, d.y}; }
                    v0 = v0 * sc; v1 = v1 * sc; u32x4 w; w.x = cvt_pk_bf16(v0[0], v0[1]); w.y = cvt_pk_bf16(v0[2], v0[3]); w.z = cvt_pk_bf16(v1[0], v1[1]); w.w = cvt_pk_bf16(v1[2], v1[3]);
                    *(u32x4*)(rowp + bj * HALF) = w; } }
    }
};
template <class Epi, class Sched, bool ALIGN_EPI = false, bool SP2 = false>
__device__ __forceinline__ void gemm_phase(PG8_LAS unsigned char* lds, const Gemm g, const Sched& S, const Epi& E) {
    const int tid = opaque_tid(), wid = __builtin_amdgcn_readfirstlane(tid >> 6), lane = tid & 63, wr = wid >> 2, wc = wid & 3, fr = lane & 15, fq = lane >> 4;
    const int K = g.K, nt = K / BK;
    unsigned voffA[2], voffB[2];
#pragma unroll
    for (int i = 0; i < 2; ++i) { int R, C; stage_rc(tid * 16 + i * 8192, R, C); const int Rb = Epi::PERM ? ((R & ~31) + perm32(R & 31)) : R;
        voffA[i] = (unsigned)(R * g.ld + C) * 2u; voffB[i] = (unsigned)(Rb * g.ld + C) * 2u; }
    const size_t kstep = (size_t)(BK * 2);
    const size_t hstep = (size_t)HALF * g.ld * 2;
    const size_t tstep = 2 * hstep;
    const unsigned ldsw = (unsigned)wid * 1024u;
    const int aoff = lds_byte(wr * 64 + fr, fq * 8), boff = lds_byte(wc * 32 + fr, fq * 8);
#define PG8_SA(b, h) (((b) * 2 + (h)) * HTB)
#define PG8_SB(b, h) ((4 + (b) * 2 + (h)) * HTB)
#define PG8_STAGE(bufoff, gbase, voff) do { _Pragma("unroll") for (int _i = 0; _i < 2; ++_i) \
        __builtin_amdgcn_global_load_lds((const unsigned*)((const char*)(gbase) + (voff)[_i]), (PG8_LAS unsigned*)(lds + (bufoff) + ldsw + _i * 8192), 16, 0, 0); } while (0)
#define PG8_LDA(dst, b, h) do { _Pragma("unroll") for (int m = 0; m < 4; ++m) _Pragma("unroll") for (int k = 0; k < 2; ++k) dst[m][k] = *(const PG8_LAS bf16x8*)(lds + PG8_SA(b, h) + aoff + m * 2048 + k * 1024); } while (0)
#define PG8_LDB(dst, b, h) do { _Pragma("unroll") for (int n = 0; n < 2; ++n) _Pragma("unroll") for (int k = 0; k < 2; ++k) dst[n][k] = *(const PG8_LAS bf16x8*)(lds + PG8_SB(b, h) + boff + n * 2048 + k * 1024); } while (0)
#define PG8_MMA(ai, bj, At, Bt) do { __builtin_amdgcn_s_setprio(1); _Pragma("unroll") for (int m = 0; m < 4; ++m) _Pragma("unroll") for (int n = 0; n < 2; ++n) _Pragma("unroll") for (int k = 0; k < 2; ++k) \
        acc[ai][bj][m][n] = __builtin_amdgcn_mfma_f32_16x16x32_bf16(Bt[n][k], At[m][k], acc[ai][bj][m][n], 0, 0, 0); __builtin_amdgcn_s_setprio(0); } while (0)
#define PG8_WAIT_V(n) asm volatile("s_waitcnt vmcnt(" #n ")" ::: "memory")
#define PG8_WAIT_L(n) asm volatile("s_waitcnt lgkmcnt(" #n ")" ::: "memory")
#define PG8_BAR __builtin_amdgcn_s_barrier()
#define PG8_SCHED __builtin_amdgcn_sched_barrier(0)
    Unit cur, nxt; int ui = 0;
    if (!S.next(0, cur)) return;
    f32x4 acc[2][2][4][2];
#pragma unroll
    for (int a = 0; a < 2; ++a)
#pragma unroll
        for (int b = 0; b < 2; ++b)
#pragma unroll
            for (int m = 0; m < 4; ++m)
#pragma unroll
                for (int n = 0; n < 2; ++n) acc[a][b][m][n] = (f32x4){0.f, 0.f, 0.f, 0.f};
    bf16x8 At[4][2], B0[2][2], B1[2][2];
    const char* cA = (const char*)g.A + (size_t)cur.pm * tstep; const char* cB = (const char*)g.Bt + (size_t)cur.pn * tstep;
    S.a_ready(cur);
    if constexpr (SP2) {
        PG8_STAGE(PG8_SB(0, 0), cB, voffB); PG8_STAGE(PG8_SB(0, 1), cB + hstep, voffB); PG8_STAGE(PG8_SA(0, 0), cA, voffA); PG8_STAGE(PG8_SA(0, 1), cA + hstep, voffA);
        if (wr == 1) PG8_BAR;
        PG8_WAIT_V(2); PG8_BAR;
        PG8_STAGE(PG8_SB(1, 0), cB + kstep, voffB); PG8_STAGE(PG8_SA(1, 0), cA + kstep, voffA); PG8_STAGE(PG8_SB(1, 1), cB + hstep + kstep, voffB);
        PG8_WAIT_V(6); PG8_BAR;
    } else {
        PG8_STAGE(PG8_SB(0, 0), cB, voffB); PG8_STAGE(PG8_SA(0, 0), cA, voffA); PG8_STAGE(PG8_SB(0, 1), cB + hstep, voffB); PG8_STAGE(PG8_SA(0, 1), cA + hstep, voffA);
        if (wr == 1) PG8_BAR;
        PG8_WAIT_V(4); PG8_BAR;
        PG8_STAGE(PG8_SB(1, 0), cB + kstep, voffB); PG8_STAGE(PG8_SA(1, 0), cA + kstep, voffA); PG8_STAGE(PG8_SB(1, 1), cB + hstep + kstep, voffB);
        PG8_WAIT_V(6); PG8_BAR;
    }
    for (;;) {
        const bool has_next = S.next(ui + 1, nxt);
        const char* nA = has_next ? (const char*)g.A + (size_t)nxt.pm * tstep : cA; const char* nB = has_next ? (const char*)g.Bt + (size_t)nxt.pn * tstep : cB;
        for (int t = 0; t < nt; t += 2) {
            const bool last = (t == nt - 2);
            const char* a1 = cA + (size_t)(t + 1) * kstep;
            const char* a2 = last ? nA : cA + (size_t)(t + 2) * kstep; const char* b2 = last ? nB : cB + (size_t)(t + 2) * kstep;
            const char* a3 = a2 + kstep; const char* b3 = b2 + kstep;
            if (last && has_next) S.a_ready(nxt);
            if constexpr (SP2) {
            PG8_LDB(B0, 0, 0); PG8_LDB(B1, 0, 1); PG8_SCHED; PG8_LDA(At, 0, 0); PG8_STAGE(PG8_SA(1, 1), a1 + hstep, voffA);
            PG8_WAIT_V(8); PG8_WAIT_L(0); PG8_BAR; PG8_MMA(0, 0, At, B0); PG8_MMA(0, 1, At, B1); PG8_BAR; PG8_SCHED;
            PG8_LDA(At, 0, 1); PG8_STAGE(PG8_SB(0, 0), b2, voffB); PG8_STAGE(PG8_SB(0, 1), b2 + hstep, voffB); PG8_STAGE(PG8_SA(0, 0), a2, voffA);
            PG8_WAIT_V(8); PG8_WAIT_L(0); PG8_BAR; PG8_MMA(1, 0, At, B0); PG8_MMA(1, 1, At, B1); PG8_BAR; PG8_SCHED;
            PG8_LDB(B0, 1, 0); PG8_LDB(B1, 1, 1); PG8_SCHED; PG8_LDA(At, 1, 0); PG8_STAGE(PG8_SA(0, 1), a2 + hstep, voffA);
            PG8_WAIT_V(8); PG8_WAIT_L(0); PG8_BAR; PG8_MMA(0, 0, At, B0); PG8_MMA(0, 1, At, B1); PG8_BAR; PG8_SCHED;
            PG8_LDA(At, 1, 1); PG8_STAGE(PG8_SB(1, 0), b3, voffB); PG8_STAGE(PG8_SB(1, 1), b3 + hstep, voffB); PG8_STAGE(PG8_SA(1, 0), a3, voffA);
            PG8_WAIT_V(8); PG8_WAIT_L(0); PG8_BAR; PG8_MMA(1, 0, At, B0); PG8_MMA(1, 1, At, B1); PG8_BAR; PG8_SCHED;
            } else {
            PG8_LDB(B0, 0, 0); PG8_SCHED; PG8_LDA(At, 0, 0); PG8_STAGE(PG8_SA(1, 1), a1 + hstep, voffA);
            PG8_WAIT_L(8); PG8_BAR; PG8_WAIT_L(0); PG8_MMA(0, 0, At, B0); PG8_BAR; PG8_SCHED;
            PG8_LDB(B1, 0, 1); PG8_STAGE(PG8_SB(0, 0), b2, voffB);
            PG8_BAR; PG8_WAIT_L(0); PG8_MMA(0, 1, At, B1); PG8_BAR;
            PG8_LDA(At, 0, 1); PG8_STAGE(PG8_SA(0, 0), a2, voffA);
            PG8_BAR; PG8_WAIT_L(0); PG8_MMA(1, 0, At, B0); PG8_BAR; PG8_SCHED;
            PG8_STAGE(PG8_SB(0, 1), b2 + hstep, voffB);
            PG8_WAIT_V(6); PG8_BAR; PG8_MMA(1, 1, At, B1); PG8_BAR;
            PG8_LDB(B0, 1, 0); PG8_SCHED; PG8_LDA(At, 1, 0); PG8_STAGE(PG8_SA(0, 1), a2 + hstep, voffA);
            PG8_WAIT_L(8); PG8_BAR; PG8_WAIT_L(0); PG8_MMA(0, 0, At, B0); PG8_BAR; PG8_SCHED;
            PG8_LDB(B1, 1, 1); PG8_STAGE(PG8_SB(1, 0), b3, voffB);
            PG8_BAR; PG8_WAIT_L(0); PG8_MMA(0, 1, At, B1); PG8_BAR;
            PG8_LDA(At, 1, 1); PG8_STAGE(PG8_SA(1, 0), a3, voffA);
            PG8_BAR; PG8_WAIT_L(0); PG8_MMA(1, 0, At, B0); PG8_BAR; PG8_SCHED;
            PG8_STAGE(PG8_SB(1, 1), b3 + hstep, voffB);
            PG8_WAIT_V(6); PG8_BAR; PG8_MMA(1, 1, At, B1); PG8_BAR;
            }
        }
        if constexpr (ALIGN_EPI) { if (wr == 0) PG8_BAR; }
        if constexpr (!Epi::AFTER_DRAIN) { E(acc, cur, wr, wc, fr, fq); S.done(cur); }
        if (!has_next) break;
#pragma unroll
        for (int a = 0; a < 2; ++a)
#pragma unroll
            for (int b = 0; b < 2; ++b)
#pragma unroll
                for (int m = 0; m < 4; ++m)
#pragma unroll
                    for (int n = 0; n < 2; ++n) acc[a][b][m][n] = (f32x4){0.f, 0.f, 0.f, 0.f};
        cur = nxt; cA = nA; cB = nB; ++ui;
        if constexpr (ALIGN_EPI) { if (wr == 1) PG8_BAR; }
    }
    PG8_WAIT_V(0);
    if constexpr (!ALIGN_EPI) { if (wr == 0) PG8_BAR; }
    PG8_BAR;
    if constexpr (Epi::AFTER_DRAIN) { E.fused(acc, cur, wr, wc, fr, fq, lds, wid, lane); S.done(cur); }
#undef PG8_SA
#undef PG8_SB
#undef PG8_STAGE
#undef PG8_LDA
#undef PG8_LDB
#undef PG8_MMA
#undef PG8_WAIT_V
#undef PG8_WAIT_L
#undef PG8_BAR
#undef PG8_SCHED
}
}

constexpr int DM = 1024, NB = 8, SEQ = 4096, DEPTH = 4, CTXL = 256, INW = 2304, DFF = 4096;
constexpr int ML = NB * SEQ;
constexpr int MC = NB * CTXL;
constexpr int MT = ML + MC;
constexpr float EPS = 1e-6f;
constexpr float QSCALE = 0.125f * 1.4426950408889634f;

constexpr size_t MiB = 1u << 20;
constexpr size_t OFF_MOD = 0;
constexpr size_t OFF_TAB = 1 * MiB;
constexpr size_t OFF_BAR = 1 * MiB + 16 * 1024;
constexpr size_t OFF_WSP = 1 * MiB + 64 * 1024;
constexpr size_t OFF_WPT = OFF_WSP + 512 * 1024;
constexpr size_t OFF_WIN = 2 * MiB;
constexpr size_t OFF_WOUT = 20 * MiB;
constexpr size_t OFF_W1 = 28 * MiB;
constexpr size_t OFF_W2 = 60 * MiB;
constexpr size_t OFF_XC = 92 * MiB;
constexpr size_t OFF_H = 100 * MiB;
constexpr size_t OFF_Z = 168 * MiB;
constexpr size_t OFF_MIX = 321 * MiB;
constexpr size_t OFF_HID = 168 * MiB;
constexpr size_t OFF_SSQ = 440 * MiB;
constexpr size_t OFF_BIN = 443 * MiB;
constexpr size_t OFF_B1 = 444 * MiB;
constexpr size_t OFF_XL = 445 * MiB;
constexpr size_t WS_NEED = 509 * MiB;

constexpr int LDS_BYTES = 147456;
constexpr int NTHR = 512;

#define LAS __attribute__((address_space(3)))
typedef unsigned short bf16;
typedef short bf16x8 __attribute__((ext_vector_type(8)));
typedef float f32x4 __attribute__((ext_vector_type(4)));
typedef float f32x16 __attribute__((ext_vector_type(16)));
typedef unsigned u32x4 __attribute__((ext_vector_type(4)));
typedef unsigned u32x2 __attribute__((ext_vector_type(2)));
typedef short s16x4 __attribute__((ext_vector_type(4)));
typedef float f32x2_t __attribute__((ext_vector_type(2)));
typedef __bf16 bf16x2_t __attribute__((ext_vector_type(2)));
typedef _Float16 h16x4 __attribute__((ext_vector_type(4)));

__device__ __forceinline__ unsigned cvtpk(float lo, float hi) { f32x2_t v = {lo, hi}; bf16x2_t b = __builtin_convertvector(v, bf16x2_t); return __builtin_bit_cast(unsigned, b); }
__device__ __forceinline__ bf16 f2bf(float f) { return (bf16)(cvtpk(f, 0.f) & 0xffffu); }
__device__ __forceinline__ float bf2f(unsigned b) { return __uint_as_float(b << 16); }
__device__ __forceinline__ float bflo(unsigned w) { return __uint_as_float(w << 16); }
__device__ __forceinline__ float bfhi(unsigned w) { return __uint_as_float(w & 0xffff0000u); }
__device__ __forceinline__ int crow(int r, int hi) { return (r & 3) + 8 * (r >> 2) + 4 * hi; }
__device__ __forceinline__ float wave_sum(float v) {
#pragma unroll
    for (int o = 1; o < 64; o <<= 1) v += __shfl_xor(v, o);
    return v;
}

__host__ __device__ __forceinline__ int rope_perm32(int j) { return 8 * ((j & 15) >> 2) + 4 * (j >> 4) + (j & 3); }
struct Params {
    const float *x, *c, *ctx, *c_ctx, *w_ada, *b_ada, *g_mix, *g_mlp, *w_in, *lq1, *lk1, *lq2, *lk2, *g_sub, *g_v, *w_sp, *b_sp, *w_pool, *s_pool, *w_out, *w1, *w2, *g_final;
    float* out; unsigned char* ws;
};

struct EpiInProj {
    static constexpr bool PERM = true, AFTER_DRAIN = false;
    bf16* Z; const float* cosT; const float* sinT; const float* ssq; const float* bias;
    __device__ __forceinline__ void operator()(const pg8::f32x4 (&acc)[2][2][4][2], const pg8::Unit& u, int wr, int wc, int fr, int fq) const {
        const bool rope = (u.pn < 4) && (u.pm < ML / 256);
        const float sc = (u.pn < 2) ? QSCALE : 1.f;
        const int row0 = u.pm * 256 + wr * 64 + fr, col0 = u.pn * 256 + wc * 32 + 8 * fq;
        const float* bp = bias + (size_t)((u.pm < ML / 256) ? (u.pm >> 4) : 8) * INW + col0;
        f32x4 bv[2][2];
#pragma unroll
        for (int bj = 0; bj < 2; ++bj)
#pragma unroll
            for (int n = 0; n < 2; ++n) bv[bj][n] = *(const f32x4*)(bp + bj * 128 + n * 4);
#pragma unroll
        for (int ai = 0; ai < 2; ++ai)
#pragma unroll
            for (int m = 0; m < 4; ++m) {
                const int row = row0 + ai * 128 + m * 16;
                float rstd;
                { const f32x4* sp = (const f32x4*)(ssq + (size_t)row * 16); const f32x4 a = sp[0] + sp[1] + sp[2] + sp[3]; rstd = rsqrtf(((a[0] + a[1]) + (a[2] + a[3])) * (1.f / DM) + EPS); }
                f32x4 cs = {1.f, 1.f, 1.f, 1.f}, sn = {0.f, 0.f, 0.f, 0.f};
                if (rope) { const int pos = (wc & 1) ? (row & 63) : ((row >> 6) & 63); cs = *(const f32x4*)(cosT + pos * 16 + 4 * fq); sn = *(const f32x4*)(sinT + pos * 16 + 4 * fq); }
                bf16* rowp = Z + (size_t)row * INW + col0;
#pragma unroll
                for (int bj = 0; bj < 2; ++bj) {
                    const f32x4 x1 = acc[ai][bj][m][0] * rstd + bv[bj][0], x2 = acc[ai][bj][m][1] * rstd + bv[bj][1];
                    const f32x4 o1 = (x1 * cs - x2 * sn) * sc, o2 = (x2 * cs + x1 * sn) * sc;
                    *(u32x4*)(rowp + bj * 128) = (u32x4){cvtpk(o1[0], o1[1]), cvtpk(o1[2], o1[3]), cvtpk(o2[0], o2[1]), cvtpk(o2[2], o2[3])};
                }
            }
    }
};
struct EpiSqRelu {
    static constexpr bool PERM = true, AFTER_DRAIN = false;
    bf16* O; int ldc; const float* ssq; const float* bias;
    __device__ __forceinline__ void operator()(const pg8::f32x4 (&acc)[2][2][4][2], const pg8::Unit& u, int wr, int wc, int fr, int fq) const {
        const int row0 = u.pm * 256 + wr * 64 + fr, col0 = u.pn * 256 + wc * 32 + 8 * fq;
        const float* bp = bias + (size_t)((u.pm < ML / 256) ? (u.pm >> 4) : 8) * DFF + col0;
        f32x4 bv[2][2];
#pragma unroll
        for (int bj = 0; bj < 2; ++bj)
#pragma unroll
            for (int n = 0; n < 2; ++n) bv[bj][n] = *(const f32x4*)(bp + bj * 128 + n * 4);
#pragma unroll
        for (int ai = 0; ai < 2; ++ai)
#pragma unroll
            for (int m = 0; m < 4; ++m) { const int row = row0 + ai * 128 + m * 16; bf16* rowp = O + (size_t)row * ldc + col0;
                float rstd;
                { const f32x4* sp = (const f32x4*)(ssq + (size_t)row * 16); const f32x4 a = sp[0] + sp[1] + sp[2] + sp[3]; rstd = rsqrtf(((a[0] + a[1]) + (a[2] + a[3])) * (1.f / DM) + EPS); }
#pragma unroll
                for (int bj = 0; bj < 2; ++bj) {
                    f32x4 v0 = acc[ai][bj][m][0] * rstd + bv[bj][0], v1 = acc[ai][bj][m][1] * rstd + bv[bj][1];
#pragma unroll
                    for (int e = 0; e < 4; ++e) { const float a = fmaxf(v0[e], 0.f), b = fmaxf(v1[e], 0.f); v0[e] = a * a; v1[e] = b * b; }
                    u32x4 w; w.x = cvtpk(v0[0], v0[1]); w.y = cvtpk(v0[2], v0[3]); w.z = cvtpk(v1[0], v1[1]); w.w = cvtpk(v1[2], v1[3]);
                    *(u32x4*)(rowp + bj * 128) = w; } }
    }
};
#ifndef EPIRES_FENCE
#define EPIRES_FENCE
#endif
struct EpiRes {
    static constexpr bool PERM = true, AFTER_DRAIN = false;
    const void* srcL; _Float16* dstL; const void* srcC; _Float16* dstC; int src_f32; const float* gate;
    const float* nxt_g; const float* nxt_sc; bf16* XG; float* ssq;
    __device__ __forceinline__ void operator()(const pg8::f32x4 (&acc)[2][2][4][2], const pg8::Unit& u, int wr, int wc, int fr, int fq) const {
        const bool lat = u.pm < ML / 256;
        const int bidx = lat ? (u.pm >> 4) : 8;
        const float* g = gate + (size_t)bidx * 6144;
        const size_t rbase = lat ? 0 : (size_t)ML * DM;
        const float* src32 = (const float*)(lat ? srcL : srcC) - rbase; const _Float16* src16 = (const _Float16*)(lat ? srcL : srcC) - rbase;
        _Float16* dst = (lat ? dstL : dstC) - rbase;
        const int row0 = u.pm * 256 + wr * 64 + fr, col0 = u.pn * 256 + wc * 32 + 8 * fq;
        const bool has_next = nxt_g != nullptr;
        float ss[2][4];
#pragma unroll
        for (int ai = 0; ai < 2; ++ai)
#pragma unroll
            for (int m = 0; m < 4; ++m) ss[ai][m] = 0.f;
#pragma unroll
        for (int bj = 0; bj < 2; ++bj) { const int col = col0 + bj * 128;
            const f32x4 gv0 = *(const f32x4*)(g + col), gv1 = *(const f32x4*)(g + col + 4);
            f32x4 gm0 = {0.f, 0.f, 0.f, 0.f}, gm1 = {0.f, 0.f, 0.f, 0.f};
            if (has_next) { const float* sc = nxt_sc + (size_t)bidx * 6144 + col;
                gm0 = *(const f32x4*)(nxt_g + col) * (*(const f32x4*)sc + 1.f); gm1 = *(const f32x4*)(nxt_g + col + 4) * (*(const f32x4*)(sc + 4) + 1.f); }
#pragma unroll
            for (int ai = 0; ai < 2; ++ai)
#pragma unroll
                for (int m = 0; m < 4; ++m) { const size_t off = (size_t)(row0 + ai * 128 + m * 16) * DM + col;
                    f32x4 x0, x1;
                    if (src_f32) { x0 = *(const f32x4*)(src32 + off); x1 = *(const f32x4*)(src32 + off + 4); }
                    else { const u32x4 raw = *(const u32x4*)(src16 + off); const u32x2 lo = {raw[0], raw[1]}, hi2 = {raw[2], raw[3]};
                        x0 = __builtin_convertvector(__builtin_bit_cast(h16x4, lo), f32x4); x1 = __builtin_convertvector(__builtin_bit_cast(h16x4, hi2), f32x4); }
                    const f32x4 n0 = x0 + gv0 * acc[ai][bj][m][0], n1 = x1 + gv1 * acc[ai][bj][m][1];
                    { const u32x2 lo = __builtin_bit_cast(u32x2, __builtin_convertvector(n0, h16x4)), hi2 = __builtin_bit_cast(u32x2, __builtin_convertvector(n1, h16x4));
                      *(u32x4*)(dst + off) = (u32x4){lo[0], lo[1], hi2[0], hi2[1]}; }
                    if (has_next) { ss[ai][m] += ((n0[0] * n0[0] + n0[1] * n0[1]) + (n0[2] * n0[2] + n0[3] * n0[3])) + ((n1[0] * n1[0] + n1[1] * n1[1]) + (n1[2] * n1[2] + n1[3] * n1[3]));
                        const f32x4 y0 = n0 * gm0, y1 = n1 * gm1;
                        *(u32x4*)(XG + off) = (u32x4){cvtpk(y0[0], y0[1]), cvtpk(y0[2], y0[3]), cvtpk(y1[0], y1[1]), cvtpk(y1[2], y1[3])}; } }
        }
        if (has_next) {
#pragma unroll
            for (int ai = 0; ai < 2; ++ai)
#pragma unroll
                for (int m = 0; m < 4; ++m) { float v = ss[ai][m]; v += __shfl_xor(v, 16); v += __shfl_xor(v, 32);
                    if (fq == 0) ssq[(size_t)(row0 + ai * 128 + m * 16) * 16 + u.pn * 4 + wc] = v; }
        }
    }
};

struct EpiPartial {
    static constexpr bool PERM = false, AFTER_DRAIN = false;
    float* PART;
    __device__ __forceinline__ void operator()(const pg8::f32x4 (&acc)[2][2][4][2], const pg8::Unit& u, int wr, int wc, int fr, int fq) const {
        const int row0 = u.pm * 256 + wr * 64 + fr, col0 = u.pn * 256 + wc * 32 + 4 * fq;
#pragma unroll
        for (int ai = 0; ai < 2; ++ai)
#pragma unroll
            for (int m = 0; m < 4; ++m)
#pragma unroll
                for (int bj = 0; bj < 2; ++bj)
#pragma unroll
                    for (int n = 0; n < 2; ++n) *(f32x4*)(PART + (size_t)(row0 + ai * 128 + m * 16) * DM + col0 + bj * 128 + n * 16) = acc[ai][bj][m][n];
    }
};
struct OneUnit {
    pg8::Unit u0;
    __device__ __forceinline__ bool next(int i, pg8::Unit& u) const { if (i) return false; u = u0; return true; }
    __device__ __forceinline__ void a_ready(const pg8::Unit&) const {}
    __device__ __forceinline__ void done(const pg8::Unit&) const {}
};
__device__ __forceinline__ void ctx_finalize_phase(_Float16* XC, const float* PART, const float* gate8, const float* nxt_g, const float* nxt_sc8, bf16* H, float* ssq, int lane, int wave) {
    const int gw = blockIdx.x * 8 + wave, NGW = gridDim.x * 8;
    for (int row = gw; row < MC; row += NGW) {
        h16x4* xr = (h16x4*)(XC + (size_t)row * DM) + lane;
        f32x4 v[4]; float s = 0.f;
#pragma unroll
        for (int j = 0; j < 4; ++j) {
            f32x4 a = {0.f, 0.f, 0.f, 0.f};
#pragma unroll
            for (int ks = 0; ks < 8; ++ks) a += *((const f32x4*)(PART + ((size_t)ks * MC + row) * DM) + lane + 64 * j);
            v[j] = __builtin_convertvector(xr[64 * j], f32x4) + *((const f32x4*)gate8 + lane + 64 * j) * a; xr[64 * j] = __builtin_convertvector(v[j], h16x4);
            s += (v[j][0] * v[j][0] + v[j][1] * v[j][1]) + (v[j][2] * v[j][2] + v[j][3] * v[j][3]); }
        const float tot = wave_sum(s);
        u32x2* o = (u32x2*)(H + (size_t)(ML + row) * DM) + lane;
#pragma unroll
        for (int j = 0; j < 4; ++j) { const f32x4 y = v[j] * *((const f32x4*)nxt_g + lane + 64 * j) * (*((const f32x4*)nxt_sc8 + lane + 64 * j) + 1.f);
            u32x2 w; w.x = cvtpk(y[0], y[1]); w.y = cvtpk(y[2], y[3]); o[64 * j] = w; }
        if (lane < 16) ssq[(size_t)(ML + row) * 16 + lane] = (lane == 0) ? tot : 0.f;
    }
}

__device__ __forceinline__ void transpose_item(const float* W, int K, int N, bf16* WT, LAS float* scr, int item, int lane, int perm_lim = 0) {
    const int nblk = N / 32, kb = item / nblk, nb = item % nblk, k0 = 64 * kb, n0 = 32 * nb;
#pragma unroll 8
    for (int i = 0; i < 32; ++i) { const int kk = 2 * i + (lane >> 5); scr[kk * 33 + (lane & 31)] = W[(size_t)(k0 + kk) * N + n0 + (lane & 31)]; }
    asm volatile("s_waitcnt lgkmcnt(0)" ::: "memory");
    const int c = lane & 7;
#pragma unroll
    for (int j = 0; j < 4; ++j) { const int n = (lane >> 3) + 8 * j; const LAS float* s = scr + (8 * c) * 33 + n;
        u32x4 o; o.x = cvtpk(s[0 * 33], s[1 * 33]); o.y = cvtpk(s[2 * 33], s[3 * 33]); o.z = cvtpk(s[4 * 33], s[5 * 33]); o.w = cvtpk(s[6 * 33], s[7 * 33]);
        const int nn = (n0 < perm_lim) ? rope_perm32(n) : n;
        *(u32x4*)(WT + (size_t)(n0 + nn) * K + k0 + 8 * c) = o; }
    asm volatile("s_waitcnt lgkmcnt(0)" ::: "memory");
}

__device__ __forceinline__ void gemv9_item(const float* Wc, int ldw, const LAS float* vec, LAS float* red, float* outc, int ldo, const float* addb, int tid, int lane, int wave, bool perm = false);
__device__ __forceinline__ void prologue(const Params& P, LAS unsigned char* lds, int tid, int lane, int wave) {
    unsigned char* ws = P.ws;
    const int G = gridDim.x, gw = blockIdx.x * 8 + wave, NGW = G * 8;
    {
        LAS float* scr = (LAS float*)(lds + wave * 16384);
        constexpr int I_IN = (DM / 64) * (INW / 32), I_OUT = (DM / 64) * (DM / 32), I_1 = (DM / 64) * (DFF / 32), I_2 = (DFF / 64) * (DM / 32), I_P = 2;
        constexpr int PER_L = I_IN + I_OUT + I_1 + I_2 + 4 * I_P;
        for (int it = gw; it < DEPTH * PER_L; it += NGW) {
            const int l = it / PER_L; int r = it % PER_L;
            if (r < I_IN) { transpose_item(P.w_in + (size_t)l * DM * INW, DM, INW, (bf16*)(ws + OFF_WIN) + (size_t)l * INW * DM, scr, r, lane, 1024); continue; } r -= I_IN;
            if (r < I_OUT) { transpose_item(P.w_out + (size_t)l * DM * DM, DM, DM, (bf16*)(ws + OFF_WOUT) + (size_t)l * DM * DM, scr, r, lane); continue; } r -= I_OUT;
            if (r < I_1) { transpose_item(P.w1 + (size_t)l * DM * DFF, DM, DFF, (bf16*)(ws + OFF_W1) + (size_t)l * DFF * DM, scr, r, lane); continue; } r -= I_1;
            if (r < I_2) { transpose_item(P.w2 + (size_t)l * DFF * DM, DFF, DM, (bf16*)(ws + OFF_W2) + (size_t)l * DM * DFF, scr, r, lane); continue; } r -= I_2;
            const int g = r / I_P; r %= I_P;
            transpose_item(P.w_pool + (size_t)(l * 4 + g) * 4096, 64, 64, (bf16*)(ws + OFF_WPT) + (size_t)(l * 4 + g) * 4096, scr, r, lane);
        }
    }
    {
        bf16* wsp = (bf16*)(ws + OFF_WSP);
        for (int i = blockIdx.x * NTHR + tid; i < DEPTH * 4 * 128 * 128 / 4; i += G * NTHR) {
            const f32x4 v = *(const f32x4*)(P.w_sp + (size_t)i * 4); u32x2 o; o.x = cvtpk(v[0], v[1]); o.y = cvtpk(v[2], v[3]); *(u32x2*)(wsp + (size_t)i * 4) = o; }
    }
    if (blockIdx.x == (unsigned)(G - 1)) {
        float* cosT = (float*)(ws + OFF_TAB); float* sinT = cosT + 1024; float* lam = cosT + 2048;
        for (int idx = tid; idx < 1024; idx += NTHR) {
            const int pos = idx >> 4, i = idx & 15;
            const float inv = __builtin_amdgcn_exp2f(-(float)i * (13.287712379549449f / 16.0f));
            const double rev0 = (double)pos * (double)inv * 0.15915494309189535; const float rev = (float)(rev0 - floor(rev0));
            cosT[idx] = __builtin_amdgcn_cosf(rev); sinT[idx] = __builtin_amdgcn_sinf(rev);
        }
        if (tid < DEPTH) {
            const int l = tid; float s1 = 0.f, s2 = 0.f;
            for (int i = 0; i < 64; ++i) { s1 += P.lq1[l * 64 + i] * P.lk1[l * 64 + i]; s2 += P.lq2[l * 64 + i] * P.lk2[l * 64 + i]; }
            const float lam_init = 0.8f - 0.6f * expf(-0.3f * (float)l);
            lam[l] = expf(s1) - expf(s2) + lam_init;
        }
    }
    __syncthreads();
    {
        LAS float* vec = (LAS float*)lds; LAS float* red = (LAS float*)(lds + 1024 * 12 * 4);
        for (int i = tid; i < 9 * 1024; i += NTHR) { const int j = i >> 10, k = i & 1023; const float v = (j < 8) ? P.c[j * 1024 + k] : P.c_ctx[k]; vec[k * 12 + j] = v / (1.f + __expf(-v)); }
        __syncthreads();
        float* mod = (float*)(ws + OFF_MOD);
        for (int it = blockIdx.x; it < DEPTH * 96; it += G) {
            const int l = it / 96, n0 = (it % 96) * 64;
            gemv9_item(P.w_ada + (size_t)l * DM * 6144 + n0, 6144, vec, red, mod + (size_t)l * 9 * 6144 + n0, 6144, P.b_ada + l * 6144 + n0, tid, lane, wave);
        }
    }
}

__device__ __forceinline__ void gemv9_item(const float* Wc  , int ldw, const LAS float* vec, LAS float* red, float* outc  , int ldo, const float* addb  , int tid, int lane, int wave, bool perm) {
    float a[9];
#pragma unroll
    for (int j = 0; j < 9; ++j) a[j] = 0.f;
    const int k0 = wave * 128; const float* W = Wc + lane;
#pragma unroll 16
    for (int k = 0; k < 128; ++k) { const float w = W[(size_t)(k0 + k) * ldw];
        const LAS f32x4* vp = (const LAS f32x4*)(vec + (k0 + k) * 12); const f32x4 v0 = vp[0], v1 = vp[1], v2 = vp[2];
        a[0] += v0[0] * w; a[1] += v0[1] * w; a[2] += v0[2] * w; a[3] += v0[3] * w; a[4] += v1[0] * w; a[5] += v1[1] * w; a[6] += v1[2] * w; a[7] += v1[3] * w; a[8] += v2[0] * w; }
#pragma unroll
    for (int j = 0; j < 9; ++j) red[(wave * 9 + j) * 64 + lane] = a[j];
    __syncthreads();
    for (int idx = tid; idx < 576; idx += NTHR) { const int j = idx >> 6, ln = idx & 63; float sacc = 0.f;
#pragma unroll
        for (int w = 0; w < 8; ++w) sacc += red[(w * 9 + j) * 64 + ln];
        const int lo_ = perm ? ((ln & 32) + rope_perm32(ln & 31)) : ln;
        outc[(size_t)j * ldo + lo_] = sacc + (addb ? addb[ln] : 0.f); }
    __syncthreads();
}
__device__ __forceinline__ void prep_phase(const Params& P, LAS unsigned char* lds, int tid, int lane, int wave) {
    unsigned char* ws = P.ws;
    const float* mod = (const float*)(ws + OFF_MOD);
    LAS float* vec = (LAS float*)lds; LAS float* red = (LAS float*)(lds + 1024 * 12 * 4);
    for (int it = blockIdx.x; it < DEPTH * 100; it += gridDim.x) {
        const int l = it / 100, r = it % 100; const bool isin = r < 36; const int cb = isin ? r : r - 36;
        const float* sh = mod + (size_t)l * 9 * 6144 + (isin ? 0 : 3) * 1024;
        for (int i = tid; i < 9 * 1024; i += NTHR) { const int j = i >> 10, k = i & 1023; vec[k * 12 + j] = sh[(size_t)j * 6144 + k]; }
        __syncthreads();
        if (isin) gemv9_item(P.w_in + (size_t)l * DM * INW + cb * 64, INW, vec, red, (float*)(ws + OFF_BIN) + (size_t)l * 9 * INW + cb * 64, INW, nullptr, tid, lane, wave, cb * 64 < 1024);
        else gemv9_item(P.w1 + (size_t)l * DM * DFF + cb * 64, DFF, vec, red, (float*)(ws + OFF_B1) + (size_t)l * 9 * DFF + cb * 64, DFF, nullptr, tid, lane, wave);
    }
    const int gw = blockIdx.x * 8 + wave, NGW = gridDim.x * 8;
    bf16* H = (bf16*)(ws + OFF_H); float* ssq = (float*)(ws + OFF_SSQ);
    f32x4 gv[4];
#pragma unroll
    for (int j = 0; j < 4; ++j) gv[j] = *((const f32x4*)P.g_mix + lane + 64 * j);
    for (int row = gw; row < MT; row += NGW) {
        const float* xr = row < ML ? P.x + (size_t)row * DM : P.ctx + (size_t)(row - ML) * DM;
        const int bidx = row < ML ? (row >> 12) : 8;
        const float* sc = mod + (size_t)bidx * 6144 + 1024;
        f32x4 v[4]; float s = 0.f;
#pragma unroll
        for (int j = 0; j < 4; ++j) { v[j] = *((const f32x4*)xr + lane + 64 * j); s += (v[j][0] * v[j][0] + v[j][1] * v[j][1]) + (v[j][2] * v[j][2] + v[j][3] * v[j][3]); }
        const float tot = wave_sum(s);
        u32x2* o = (u32x2*)(H + (size_t)row * DM) + lane;
#pragma unroll
        for (int j = 0; j < 4; ++j) { const f32x4 scv = *((const f32x4*)sc + lane + 64 * j);
            const f32x4 y = v[j] * gv[j] * (scv + 1.f); u32x2 w; w.x = cvtpk(y[0], y[1]); w.y = cvtpk(y[2], y[3]); o[64 * j] = w; }
        if (lane < 16) ssq[(size_t)row * 16 + lane] = (lane == 0) ? tot : 0.f;
    }
}
__device__ __forceinline__ void final_norm_phase(const _Float16* xl, float* out, const float* g, int lane, int wave) {
    const int gw = blockIdx.x * 8 + wave, NGW = gridDim.x * 8;
    f32x4 gv[4];
#pragma unroll
    for (int j = 0; j < 4; ++j) gv[j] = *((const f32x4*)g + lane + 64 * j);
    for (int row = gw; row < ML; row += NGW) {
        const h16x4* xr = (const h16x4*)(xl + (size_t)row * DM) + lane; f32x4* orow = (f32x4*)(out + (size_t)row * DM) + lane;
        f32x4 v[4]; float s = 0.f;
#pragma unroll
        for (int j = 0; j < 4; ++j) { v[j] = __builtin_convertvector(xr[64 * j], f32x4); s += (v[j][0] * v[j][0] + v[j][1] * v[j][1]) + (v[j][2] * v[j][2] + v[j][3] * v[j][3]); }
        const float rstd = rsqrtf(wave_sum(s) * (1.f / DM) + EPS);
#pragma unroll
        for (int j = 0; j < 4; ++j) orow[64 * j] = v[j] * rstd * gv[j];
    }
}

constexpr int AT_KV = 0;
constexpr int AT_WS = 65536;
constexpr int AT_EX = 67584;
constexpr float THR = 8.f;

__device__ __forceinline__ void glds16(const void* gsrc, unsigned lds_dst) { unsigned keep;
    asm volatile("s_mov_b32 %0, m0\n\ts_mov_b32 m0, %2\n\ts_nop 0\n\tglobal_load_lds_dwordx4 %1, off\n\ts_mov_b32 m0, %0" : "=&s"(keep) : "v"(gsrc), "s"(lds_dst) : "memory"); }
__device__ __forceinline__ s16x4 vtr(const LAS unsigned char* p) { return __builtin_bit_cast(s16x4, __builtin_amdgcn_ds_read_tr16_b64_v4i16((LAS s16x4*)p)); }

__device__ __forceinline__ void attn_unit(const bf16* Z, bf16* MIX, int qrow0, int h, int ka, int nta, int kb, int ntb, float lam, float post, const float* gsub, LAS unsigned char* lds, int tid, int lane, int wave) {
    const int r32 = lane & 31, hi = lane >> 5, comp = wave >> 2, rg = wave & 3;
    const int NT = nta + ntb;
    const unsigned lds0 = (unsigned)(size_t)lds;
    unsigned ksrc[2], vsrc[2], kdst[2], vdst[2];
#pragma unroll
    for (int u = 0; u < 2; ++u) { const int bk = wave + 8 * u;
        { const int cmp = bk >> 3, j = bk & 7, kl = lane >> 3, c = (lane & 7) ^ kl; ksrc[u] = (unsigned)((8 * j + kl) * INW + 512 + h * 128 + cmp * 64 + c * 8); kdst[u] = (unsigned)(cmp * 8192 + j * 1024); }
        { const int db = bk >> 2, p = bk & 3, kl = lane >> 2, ch = lane & 3; vsrc[u] = (unsigned)((16 * p + kl) * INW + 1024 + h * 128 + db * 32 + ch * 8); vdst[u] = (unsigned)(32768 + db * 4096 + p * 1024); } }
#define AT_ROW(t) (((t) < nta) ? ka + 64 * (t) : kb + 64 * ((t) - nta))
#define AT_DMAK(t, buf) do { const bf16* rb_ = Z + (size_t)AT_ROW(t) * INW; _Pragma("unroll") for (int u = 0; u < 2; ++u) glds16(rb_ + ksrc[u], (unsigned)__builtin_amdgcn_readfirstlane(lds0 + (buf) * 16384 + kdst[u])); } while (0)
#define AT_DMAV(t, buf) do { const bf16* rb_ = Z + (size_t)AT_ROW(t) * INW; _Pragma("unroll") for (int u = 0; u < 2; ++u) glds16(rb_ + vsrc[u], (unsigned)__builtin_amdgcn_readfirstlane(lds0 + (buf) * 16384 + vdst[u])); } while (0)
#define AT_WAITBAR() do { asm volatile("s_waitcnt vmcnt(0)" ::: "memory"); __syncthreads(); } while (0)
    AT_DMAK(0, 0); AT_DMAK(1, 1); AT_DMAV(0, 0);
    bf16x8 qr[4];
    { const bf16* qp = Z + (size_t)(qrow0 + rg * 32 + r32) * INW + h * 128 + comp * 64 + hi * 8;
#pragma unroll
      for (int d0 = 0; d0 < 4; ++d0) qr[d0] = *(const bf16x8*)(qp + d0 * 16); }
    AT_WAITBAR();
    LAS float* wsf = (LAS float*)(lds + AT_WS) + wave * 64;
    f32x16 o[4];
#pragma unroll
    for (int d = 0; d < 4; ++d) o[d] = f32x16{};
    f32x16 negm = f32x16{};
    float mhat = 0.f, lsum = 0.f;
    const int koff = comp * 8192 + r32 * 128;
    const int voff = 32768 + ((lane >> 4) & 1) * 32 + (lane & 3) * 8 + (4 * hi + ((lane & 15) >> 2)) * 64;
    f32x16 C0, C1, P0, P1;
#define AT_ROWMAX(rm) do { float a_ = fmaxf(fmaxf(C0[0], C0[1]), C1[0]), b_ = fmaxf(fmaxf(C0[2], C0[3]), C1[1]); a_ = fmaxf(fmaxf(a_, C1[2]), C1[3]); \
        _Pragma("unroll") for (int r = 4; r < 16; r += 4) { a_ = fmaxf(fmaxf(a_, C0[r]), C0[r + 1]); b_ = fmaxf(fmaxf(b_, C0[r + 2]), C0[r + 3]); a_ = fmaxf(fmaxf(a_, C1[r]), C1[r + 1]); b_ = fmaxf(fmaxf(b_, C1[r + 2]), C1[r + 3]); } \
        rm = fmaxf(a_, b_); rm = fmaxf(rm, __shfl_xor(rm, 32)); } while (0)
    {
        const LAS unsigned char* kb_ = lds;
        C0 = negm; C1 = negm;
#pragma unroll
        for (int d0 = 0; d0 < 4; ++d0) { const int sw = (((2 * d0 + hi) ^ (r32 & 7)) << 4);
            C0 = __builtin_amdgcn_mfma_f32_32x32x16_bf16(*(const LAS bf16x8*)(kb_ + koff + sw), qr[d0], C0, 0, 0, 0);
            C1 = __builtin_amdgcn_mfma_f32_32x32x16_bf16(*(const LAS bf16x8*)(kb_ + koff + 32 * 128 + sw), qr[d0], C1, 0, 0, 0); }
        float rm; AT_ROWMAX(rm);
        mhat = rm;
#pragma unroll
        for (int r = 0; r < 16; ++r) { P0[r] = __builtin_amdgcn_exp2f(C0[r] - rm); P1[r] = __builtin_amdgcn_exp2f(C1[r] - rm); negm[r] = -mhat; }
    }
    __syncthreads();
    if (wave >= 4) __builtin_amdgcn_s_setprio(1);
    for (int t = 1; t < NT; ++t) {
        const LAS unsigned char* kb_ = lds + (t & 1) * 16384;
        const LAS unsigned char* vb_ = lds + ((t - 1) & 1) * 16384 + voff;
        if (t + 1 < NT) AT_DMAK(t + 1, (t + 1) & 1);
        AT_DMAV(t, t & 1);
        u32x4 pw[4]; float sacc = 0.f;
        C0 = negm; C1 = negm;
#pragma unroll
        for (int d0 = 0; d0 < 4; ++d0) { const int sw = (((2 * d0 + hi) ^ (r32 & 7)) << 4);
            C0 = __builtin_amdgcn_mfma_f32_32x32x16_bf16(*(const LAS bf16x8*)(kb_ + koff + sw), qr[d0], C0, 0, 0, 0);
            sacc += (P0[4 * d0] + P0[4 * d0 + 1]) + (P0[4 * d0 + 2] + P0[4 * d0 + 3]);
            pw[d0 >> 1][(d0 & 1) * 2] = cvtpk(P0[4 * d0], P0[4 * d0 + 1]); pw[d0 >> 1][(d0 & 1) * 2 + 1] = cvtpk(P0[4 * d0 + 2], P0[4 * d0 + 3]);
            C1 = __builtin_amdgcn_mfma_f32_32x32x16_bf16(*(const LAS bf16x8*)(kb_ + koff + 32 * 128 + sw), qr[d0], C1, 0, 0, 0);
            sacc += (P1[4 * d0] + P1[4 * d0 + 1]) + (P1[4 * d0 + 2] + P1[4 * d0 + 3]);
            pw[2 + (d0 >> 1)][(d0 & 1) * 2] = cvtpk(P1[4 * d0], P1[4 * d0 + 1]); pw[2 + (d0 >> 1)][(d0 & 1) * 2 + 1] = cvtpk(P1[4 * d0 + 2], P1[4 * d0 + 3]); }
        lsum += sacc;
        float rm; AT_ROWMAX(rm);
        bool resc = false;
        if (__any(rm > THR)) {
            const float dl = fmaxf(rm, 0.f);
            mhat += dl;
#pragma unroll
            for (int r = 0; r < 16; ++r) { C0[r] -= dl; C1[r] -= dl; negm[r] = -mhat; }
            const float f = __builtin_amdgcn_exp2f(-dl);
            lsum *= f;
            if (hi == 0) wsf[r32] = f;
            resc = true;
        }
#pragma unroll
        for (int d0 = 0; d0 < 4; ++d0)
#pragma unroll
            for (int ks = 0; ks < 4; ++ks) {
                const s16x4 lo = vtr(vb_ + d0 * 4096 + ks * 1024), hh = vtr(vb_ + d0 * 4096 + ks * 1024 + 512);
                const bf16x8 vf = (bf16x8){lo[0], lo[1], lo[2], lo[3], hh[0], hh[1], hh[2], hh[3]};
                o[d0] = __builtin_amdgcn_mfma_f32_32x32x16_bf16(__builtin_bit_cast(bf16x8, pw[ks]), vf, o[d0], 0, 0, 0);
                const int e = (d0 * 4 + ks);
                if (e < 8) { P0[2 * e] = __builtin_amdgcn_exp2f(C0[2 * e]); P0[2 * e + 1] = __builtin_amdgcn_exp2f(C0[2 * e + 1]); }
                else { P1[2 * e - 16] = __builtin_amdgcn_exp2f(C1[2 * e - 16]); P1[2 * e - 15] = __builtin_amdgcn_exp2f(C1[2 * e - 15]); }
            }
        if (resc) {
#pragma unroll
            for (int r = 0; r < 16; ++r) { const float fr_ = wsf[crow(r, hi)];
#pragma unroll
                for (int d = 0; d < 4; ++d) o[d][r] *= fr_; }
        }
        AT_WAITBAR();
    }
    __builtin_amdgcn_s_setprio(0);
    {
        const LAS unsigned char* vb_ = lds + ((NT - 1) & 1) * 16384 + voff;
        float sacc = 0.f;
#pragma unroll
        for (int r = 0; r < 16; ++r) sacc += P0[r] + P1[r];
        lsum += sacc;
        u32x4 pw[4];
        pw[0] = (u32x4){cvtpk(P0[0], P0[1]), cvtpk(P0[2], P0[3]), cvtpk(P0[4], P0[5]), cvtpk(P0[6], P0[7])};
        pw[1] = (u32x4){cvtpk(P0[8], P0[9]), cvtpk(P0[10], P0[11]), cvtpk(P0[12], P0[13]), cvtpk(P0[14], P0[15])};
        pw[2] = (u32x4){cvtpk(P1[0], P1[1]), cvtpk(P1[2], P1[3]), cvtpk(P1[4], P1[5]), cvtpk(P1[6], P1[7])};
        pw[3] = (u32x4){cvtpk(P1[8], P1[9]), cvtpk(P1[10], P1[11]), cvtpk(P1[12], P1[13]), cvtpk(P1[14], P1[15])};
#pragma unroll
        for (int d0 = 0; d0 < 4; ++d0)
#pragma unroll
            for (int ks = 0; ks < 4; ++ks) {
                const s16x4 lo = vtr(vb_ + d0 * 4096 + ks * 1024), hh = vtr(vb_ + d0 * 4096 + ks * 1024 + 512);
                const bf16x8 vf = (bf16x8){lo[0], lo[1], lo[2], lo[3], hh[0], hh[1], hh[2], hh[3]};
                o[d0] = __builtin_amdgcn_mfma_f32_32x32x16_bf16(__builtin_bit_cast(bf16x8, pw[ks]), vf, o[d0], 0, 0, 0);
            }
    }
#undef AT_ROW
#undef AT_DMAK
#undef AT_DMAV
#undef AT_WAITBAR
#undef AT_ROWMAX
    lsum += __shfl_xor(lsum, 32);
    const float inv = (comp == 0 ? 1.f : lam) / lsum;
    if (hi == 0) wsf[r32] = inv;
    asm volatile("s_waitcnt lgkmcnt(0)" ::: "memory");
    float rl[16];
#pragma unroll
    for (int r = 0; r < 16; ++r) rl[r] = wsf[crow(r, hi)];
    LAS float* ex = (LAS float*)(lds + AT_EX) + rg * 4096 + lane;
    if (comp == 1) {
#pragma unroll
        for (int d = 0; d < 4; ++d)
#pragma unroll
            for (int r = 0; r < 16; ++r) ex[(d * 16 + r) * 64] = o[d][r] * rl[r];
    }
    __syncthreads();
    if (comp == 0) {
        float ss[16];
#pragma unroll
        for (int r = 0; r < 16; ++r) { float s = 0.f;
#pragma unroll
            for (int d = 0; d < 4; ++d) { const float a = o[d][r] * rl[r] - ex[(d * 16 + r) * 64]; o[d][r] = a; s += a * a; }
            ss[r] = s; }
#pragma unroll
        for (int r = 0; r < 16; ++r) {
#pragma unroll
            for (int off = 1; off < 32; off <<= 1) ss[r] += __shfl_xor(ss[r], off);
            ss[r] = rsqrtf(ss[r] * (1.f / 128.f) + EPS) * post; }
        LAS bf16* stg = (LAS bf16*)((LAS float*)(lds + AT_EX) + rg * 4096);
#pragma unroll
        for (int d = 0; d < 4; ++d) { const float gs = gsub[d * 32 + r32];
#pragma unroll
            for (int r = 0; r < 16; ++r) stg[crow(r, hi) * 136 + d * 32 + r32] = f2bf(o[d][r] * ss[r] * gs); }
#pragma unroll
        for (int i = 0; i < 8; ++i) { const int idx = lane + 64 * i, row = idx >> 4, ch = idx & 15;
            const u32x4 v = *(const LAS u32x4*)(stg + row * 136 + ch * 8);
            *(u32x4*)(MIX + (size_t)(qrow0 + rg * 32 + row) * DM + h * 128 + ch * 8) = v; }
    }
    __syncthreads();
}

__device__ __forceinline__ void gate_item(const bf16* Z, bf16* MIX, int tok0, int g, const bf16* Wsp_lg, const float* bsp_lg, const float* gv_l, LAS unsigned char* lds, int tid, int lane, int wave) {
    LAS bf16* vnT = (LAS bf16*)lds;
    {
        const int q = tid >> 2, cq = tid & 3;
        const bf16* src = Z + (size_t)(tok0 + q) * INW + 1792 + g * 64 + cq * 16;
        const u32x4 a = *(const u32x4*)src, b = *(const u32x4*)(src + 8);
        float x[16];
#pragma unroll
        for (int i = 0; i < 4; ++i) { x[2 * i] = bflo(a[i]); x[2 * i + 1] = bfhi(a[i]); x[8 + 2 * i] = bflo(b[i]); x[8 + 2 * i + 1] = bfhi(b[i]); }
        float ss = 0.f;
#pragma unroll
        for (int i = 0; i < 16; ++i) ss += x[i] * x[i];
        ss += __shfl_xor(ss, 1); ss += __shfl_xor(ss, 2);
        const float rstd = rsqrtf(ss * (1.f / 64.f) + EPS);
#pragma unroll
        for (int i = 0; i < 16; ++i) vnT[(cq * 16 + i) * 136 + q] = f2bf(x[i] * rstd * gv_l[g * 64 + cq * 16 + i]);
    }
    __syncthreads();
    const int r32 = lane & 31, hi = lane >> 5, pb = wave & 3, cb = wave >> 2;
    f32x16 acc = f32x16{};
#pragma unroll
    for (int s = 0; s < 8; ++s) {
        const bf16x8 A = *(const bf16x8*)(Wsp_lg + (size_t)(pb * 32 + r32) * 128 + 16 * s + 8 * hi);
        const bf16x8 B = *(const LAS bf16x8*)(vnT + (cb * 32 + r32) * 136 + 16 * s + 8 * hi);
        acc = __builtin_amdgcn_mfma_f32_32x32x16_bf16(A, B, acc, 0, 0, 0);
    }
    const int c = cb * 32 + r32;
#pragma unroll
    for (int r = 0; r < 16; ++r) { const int p = pb * 32 + crow(r, hi); const size_t tok = (size_t)(tok0 + p);
        const float u = bf2f(Z[tok * INW + 1536 + g * 64 + c]);
        MIX[tok * DM + 512 + g * 64 + c] = f2bf((acc[r] + bsp_lg[p]) * u); }
    __syncthreads();
}

__device__ __forceinline__ void pool_item(const bf16* Z, bf16* MIX, int tok0, int g, const bf16* WpT_lg, const float* sp_l, LAS unsigned char* lds, int tid, int lane, int wave) {
    LAS bf16* pt = (LAS bf16*)lds;
    LAS bf16* dT = (LAS bf16*)(lds + 144 * 72 * 2);
    const int TS = tok0 < ML ? SEQ : CTXL, pos0 = tok0 & (TS - 1);
    for (int idx = tid; idx < 144 * 8; idx += NTHR) { const int row = idx >> 3, ch = idx & 7, pos = pos0 - 8 + row;
        u32x4 v = {0u, 0u, 0u, 0u};
        if (pos >= 0 && pos < TS) v = *(const u32x4*)(Z + (size_t)(tok0 - 8 + row) * INW + 2048 + g * 64 + ch * 8);
        *(LAS u32x4*)(pt + row * 72 + ch * 8) = v; }
    __syncthreads();
    {
        const int t = tid >> 2, cq = tid & 3, w = 2 << g, half = w >> 1, pos = pos0 + t;
        const int lo = max(pos - half, 0), hi_ = min(pos + half, TS);
        const float rc = 1.f / (float)(hi_ - lo);
        float sum[16];
#pragma unroll
        for (int i = 0; i < 16; ++i) sum[i] = 0.f;
        for (int k = 0; k < w; ++k) { const LAS bf16* rp = pt + (t + 8 - half + k) * 72 + cq * 16;
            const u32x4 a = *(const LAS u32x4*)rp, b = *(const LAS u32x4*)(rp + 8);
#pragma unroll
            for (int i = 0; i < 4; ++i) { sum[2 * i] += bflo(a[i]); sum[2 * i + 1] += bfhi(a[i]); sum[8 + 2 * i] += bflo(b[i]); sum[8 + 2 * i + 1] += bfhi(b[i]); } }
        const LAS bf16* xp = pt + (t + 8) * 72 + cq * 16;
        const u32x4 a = *(const LAS u32x4*)xp, b = *(const LAS u32x4*)(xp + 8);
        float x[16];
#pragma unroll
        for (int i = 0; i < 4; ++i) { x[2 * i] = bflo(a[i]); x[2 * i + 1] = bfhi(a[i]); x[8 + 2 * i] = bflo(b[i]); x[8 + 2 * i + 1] = bfhi(b[i]); }
        u32x4 o0, o1;
#pragma unroll
        for (int i = 0; i < 4; ++i) { o0[i] = cvtpk(sum[2 * i] * rc - x[2 * i], sum[2 * i + 1] * rc - x[2 * i + 1]); o1[i] = cvtpk(sum[8 + 2 * i] * rc - x[8 + 2 * i], sum[8 + 2 * i + 1] * rc - x[8 + 2 * i + 1]); }
        *(LAS u32x4*)(dT + t * 72 + cq * 16) = o0; *(LAS u32x4*)(dT + t * 72 + cq * 16 + 8) = o1;
    }
    __syncthreads();
    const int r32 = lane & 31, hi = lane >> 5, tb = wave & 3, eb = wave >> 2;
    f32x16 acc = f32x16{};
#pragma unroll
    for (int s = 0; s < 4; ++s) {
        const bf16x8 A = *(const LAS bf16x8*)(dT + (tb * 32 + r32) * 72 + 16 * s + 8 * hi);
        const bf16x8 B = *(const bf16x8*)(WpT_lg + (size_t)(eb * 32 + r32) * 64 + 16 * s + 8 * hi);
        acc = __builtin_amdgcn_mfma_f32_32x32x16_bf16(A, B, acc, 0, 0, 0);
    }
    const int e = eb * 32 + r32; const float sp = sp_l[g * 64 + e];
#pragma unroll
    for (int r = 0; r < 16; ++r) { const size_t tok = (size_t)(tok0 + tb * 32 + crow(r, hi)); MIX[tok * DM + 768 + g * 64 + e] = f2bf(acc[r] * sp); }
    __syncthreads();
}

__device__ __forceinline__ void small_item(const bf16* Z, bf16* MIX, int tok0, int g, const bf16* Wsp_lg, const float* bsp_lg, const float* gv_l, const bf16* WpT_lg, const float* sp_l, LAS unsigned char* lds, int tid, int lane, int wave) {
    LAS bf16* vnT = (LAS bf16*)lds;
    LAS bf16* pt = (LAS bf16*)(lds + 17408);
    LAS bf16* dT = (LAS bf16*)(lds + 38144);
    LAS bf16* uT = (LAS bf16*)(lds + 56576);
    LAS bf16* og = (LAS bf16*)(lds + 75008);
    LAS bf16* op = (LAS bf16*)(lds + 93440);
    const int TS = tok0 < ML ? SEQ : CTXL, pos0 = tok0 & (TS - 1);
    const int r32 = lane & 31, hi = lane >> 5, rb = wave & 3, cb = wave >> 2;
    const int q = tid >> 2, cq = tid & 3;
    const bf16* zrow = Z + (size_t)(tok0 + q) * INW + g * 64 + cq * 16;
    const u32x4 ga = *(const u32x4*)(zrow + 1792), gb = *(const u32x4*)(zrow + 1792 + 8);
    const u32x4 ua = *(const u32x4*)(zrow + 1536), ub = *(const u32x4*)(zrow + 1536 + 8);
    u32x4 pv[3]; int prow[3];
#pragma unroll
    for (int i = 0; i < 3; ++i) { const int idx = tid + NTHR * i; prow[i] = idx >> 3; const int ch = idx & 7, pos = pos0 - 8 + prow[i];
        pv[i] = (u32x4){0u, 0u, 0u, 0u};
        if (idx < 144 * 8 && pos >= 0 && pos < TS) pv[i] = *(const u32x4*)(Z + (size_t)(tok0 - 8 + prow[i]) * INW + 2048 + g * 64 + ch * 8); }
    bf16x8 Ag[8];
#pragma unroll
    for (int s_ = 0; s_ < 8; ++s_) Ag[s_] = *(const bf16x8*)(Wsp_lg + (size_t)(rb * 32 + r32) * 128 + 16 * s_ + 8 * hi);
    {
        float x[16];
#pragma unroll
        for (int i = 0; i < 4; ++i) { x[2 * i] = bflo(ga[i]); x[2 * i + 1] = bfhi(ga[i]); x[8 + 2 * i] = bflo(gb[i]); x[8 + 2 * i + 1] = bfhi(gb[i]); }
        float ss = 0.f;
#pragma unroll
        for (int i = 0; i < 16; ++i) ss += x[i] * x[i];
        ss += __shfl_xor(ss, 1); ss += __shfl_xor(ss, 2);
        const float rstd = rsqrtf(ss * (1.f / 64.f) + EPS);
#pragma unroll
        for (int i = 0; i < 16; ++i) vnT[(cq * 16 + i) * 136 + q] = f2bf(x[i] * rstd * gv_l[g * 64 + cq * 16 + i]);
        *(LAS u32x4*)(uT + q * 72 + cq * 16) = ua; *(LAS u32x4*)(uT + q * 72 + cq * 16 + 8) = ub;
#pragma unroll
        for (int i = 0; i < 3; ++i) { const int idx = tid + NTHR * i; if (idx < 144 * 8) *(LAS u32x4*)(pt + prow[i] * 72 + (idx & 7) * 8) = pv[i]; }
    }
    __syncthreads();
    {
        const int t = q, w = 2 << g, half = w >> 1, pos = pos0 + t;
        const int lo = max(pos - half, 0), hi_ = min(pos + half, TS);
        const float rc = 1.f / (float)(hi_ - lo);
        float sum[16];
#pragma unroll
        for (int i = 0; i < 16; ++i) sum[i] = 0.f;
        for (int k = 0; k < w; ++k) { const LAS bf16* rp = pt + (t + 8 - half + k) * 72 + cq * 16;
            const u32x4 a = *(const LAS u32x4*)rp, b = *(const LAS u32x4*)(rp + 8);
#pragma unroll
            for (int i = 0; i < 4; ++i) { sum[2 * i] += bflo(a[i]); sum[2 * i + 1] += bfhi(a[i]); sum[8 + 2 * i] += bflo(b[i]); sum[8 + 2 * i + 1] += bfhi(b[i]); } }
        const LAS bf16* xp = pt + (t + 8) * 72 + cq * 16;
        const u32x4 a = *(const LAS u32x4*)xp, b = *(const LAS u32x4*)(xp + 8);
        float x[16];
#pragma unroll
        for (int i = 0; i < 4; ++i) { x[2 * i] = bflo(a[i]); x[2 * i + 1] = bfhi(a[i]); x[8 + 2 * i] = bflo(b[i]); x[8 + 2 * i + 1] = bfhi(b[i]); }
        u32x4 o0, o1;
#pragma unroll
        for (int i = 0; i < 4; ++i) { o0[i] = cvtpk(sum[2 * i] * rc - x[2 * i], sum[2 * i + 1] * rc - x[2 * i + 1]); o1[i] = cvtpk(sum[8 + 2 * i] * rc - x[8 + 2 * i], sum[8 + 2 * i + 1] * rc - x[8 + 2 * i + 1]); }
        *(LAS u32x4*)(dT + t * 72 + cq * 16) = o0; *(LAS u32x4*)(dT + t * 72 + cq * 16 + 8) = o1;
    }
    {
        f32x16 acc = f32x16{};
#pragma unroll
        for (int s_ = 0; s_ < 8; ++s_) { const bf16x8 B = *(const LAS bf16x8*)(vnT + (cb * 32 + r32) * 136 + 16 * s_ + 8 * hi); acc = __builtin_amdgcn_mfma_f32_32x32x16_bf16(Ag[s_], B, acc, 0, 0, 0); }
        const int c = cb * 32 + r32;
#pragma unroll
        for (int r = 0; r < 16; ++r) { const int p = rb * 32 + crow(r, hi);
            og[p * 72 + c] = f2bf((acc[r] + bsp_lg[p]) * bf2f(uT[p * 72 + c])); }
    }
    __syncthreads();
    {
        f32x16 acc = f32x16{};
#pragma unroll
        for (int s_ = 0; s_ < 4; ++s_) {
            const bf16x8 A = *(const LAS bf16x8*)(dT + (rb * 32 + r32) * 72 + 16 * s_ + 8 * hi);
            const bf16x8 B = *(const bf16x8*)(WpT_lg + (size_t)(cb * 32 + r32) * 64 + 16 * s_ + 8 * hi);
            acc = __builtin_amdgcn_mfma_f32_32x32x16_bf16(A, B, acc, 0, 0, 0); }
        const int e = cb * 32 + r32; const float sp = sp_l[g * 64 + e];
#pragma unroll
        for (int r = 0; r < 16; ++r) op[(rb * 32 + crow(r, hi)) * 72 + e] = f2bf(acc[r] * sp);
    }
    __syncthreads();
    {
        bf16* mrow = MIX + (size_t)(tok0 + q) * DM + g * 64 + cq * 16;
        *(u32x4*)(mrow + 512) = *(const LAS u32x4*)(og + q * 72 + cq * 16); *(u32x4*)(mrow + 512 + 8) = *(const LAS u32x4*)(og + q * 72 + cq * 16 + 8);
        *(u32x4*)(mrow + 768) = *(const LAS u32x4*)(op + q * 72 + cq * 16); *(u32x4*)(mrow + 768 + 8) = *(const LAS u32x4*)(op + q * 72 + cq * 16 + 8);
    }
}

#define XB_TMO      128
#define XB_XCNT(j)  (256  + 64 * (j))
#define XB_XSUB(j)  (1280 + 64 * (j))
#define XB_XGEN(j)  (2304 + 64 * (j))
#define XB_TOP      3328
#define XB_TOPGEN   3392
#define XCD_BAR_WORDS 3456
#define XB_SPIN_CAP (1u << 18)

__device__ __forceinline__ unsigned xb_ld(unsigned* p)              { return __hip_atomic_load(p, __ATOMIC_RELAXED, __HIP_MEMORY_SCOPE_AGENT); }
__device__ __forceinline__ unsigned xb_add(unsigned* p, unsigned v) { return __hip_atomic_fetch_add(p, v, __ATOMIC_RELAXED, __HIP_MEMORY_SCOPE_AGENT); }
__device__ __forceinline__ unsigned xb_xcc_id() { return (unsigned)__builtin_amdgcn_s_getreg((3 << 11) | 20) & 0xFu; }
#define XB_SPIN(cond, bar) do { unsigned _sp = 0; while (cond) { __builtin_amdgcn_s_sleep(1); \
    if ((++_sp & 255u) == 0u) { if (xb_ld(&(bar)[XB_TMO])) break; if (_sp > XB_SPIN_CAP) { atomicAdd(&(bar)[XB_TMO], 1u); break; } } } } while (0)

struct XcdBarrier {
    unsigned* bar; unsigned x;
    volatile LAS unsigned* st;
};

__device__ __forceinline__ XcdBarrier xcd_barrier_post(unsigned* bar, volatile LAS unsigned* st) {
    XcdBarrier b; b.bar = bar; b.x = xb_xcc_id(); b.st = st;
    if (threadIdx.x == 0) (void)xb_add(&bar[XB_XCNT(b.x)], 1u);
    return b;
}
__device__ __forceinline__ void xcd_barrier_complete(unsigned* bar, unsigned x, unsigned& nloc, unsigned& nx) {
    const unsigned G = gridDim.x * gridDim.y * gridDim.z;
    unsigned sum, cnt, mine, sp = 0u;
    for (;;) {
        sum = 0u; cnt = 0u; mine = 0u;
#pragma unroll
        for (unsigned j = 0; j < 16; ++j) { const unsigned c = xb_ld(&bar[XB_XCNT(j)]); sum += c; cnt += (c > 0u) ? 1u : 0u; mine = (j == x) ? c : mine; }
        if (sum == G) break;
        __builtin_amdgcn_s_sleep(1);
        if ((++sp & 255u) == 0u) { if (xb_ld(&bar[XB_TMO])) break; if (sp > XB_SPIN_CAP) { atomicAdd(&bar[XB_TMO], 1u); break; } }
    }
    nloc = mine > 0u ? mine : 1u; nx = cnt > 0u ? cnt : 1u;
}

__device__ __forceinline__ void xcd_barrier(const XcdBarrier& b) {
    asm volatile("s_waitcnt vmcnt(0)" ::: "memory");
    __syncthreads();
    if (threadIdx.x == 0) {
        unsigned* bar = b.bar;
        __builtin_amdgcn_s_waitcnt(0);
        unsigned nloc = b.st[0], nx = b.st[1];
        if (nloc == 0u) { xcd_barrier_complete(bar, b.x, nloc, nx); b.st[0] = nloc; b.st[1] = nx; }
        const unsigned old = xb_add(&bar[XB_XSUB(b.x)], 1u);
        const unsigned gen = old / nloc;
        if (old + 1u == (gen + 1u) * nloc) {
            __builtin_amdgcn_fence(__ATOMIC_RELEASE, "agent");
            asm volatile("s_waitcnt vmcnt(0)" ::: "memory");
            const unsigned og = xb_add(&bar[XB_TOP], 1u);
            const unsigned tg = og / nx;
            if (og + 1u == (tg + 1u) * nx) xb_add(&bar[XB_TOPGEN], 1u);
            else XB_SPIN(xb_ld(&bar[XB_TOPGEN]) == tg, bar);
            __builtin_amdgcn_fence(__ATOMIC_ACQUIRE, "agent");
            xb_add(&bar[XB_XGEN(b.x)], 1u);
            asm volatile("s_waitcnt vmcnt(0)" ::: "memory");
        } else {
            XB_SPIN(xb_ld(&bar[XB_XGEN(b.x)]) == gen, bar);
            __builtin_amdgcn_fence(__ATOMIC_ACQUIRE, "agent");
            asm volatile("s_waitcnt vmcnt(0)" ::: "memory");
        }
    }
    __syncthreads();
}

__global__ void __launch_bounds__(NTHR, 2) fwd_megakernel(Params P) {
    extern __shared__ __attribute__((aligned(16))) unsigned char lds_raw[];
    LAS unsigned char* lds = (LAS unsigned char*)lds_raw;
    cg::grid_group grid = cg::this_grid();
    const int G = gridDim.x, bid = blockIdx.x;
#define TLW const int tid = opaque_tid(), lane = tid & 63, wave = __builtin_amdgcn_readfirstlane(tid >> 6); (void)tid; (void)lane; (void)wave
    unsigned char* ws = P.ws;
    float* mod = (float*)(ws + OFF_MOD);
    const float* cosT = (const float*)(ws + OFF_TAB); const float* sinT = cosT + 1024; const float* lamv = cosT + 2048;
    bf16* H = (bf16*)(ws + OFF_H); bf16* Z = (bf16*)(ws + OFF_Z); bf16* MIX = (bf16*)(ws + OFF_MIX); bf16* HID = (bf16*)(ws + OFF_HID);
    _Float16* XC = (_Float16*)(ws + OFF_XC); _Float16* XL = (_Float16*)(ws + OFF_XL);

    {   TLW;
        if (bid == 0) for (int i = tid; i < XCD_BAR_WORDS; i += NTHR) ((unsigned*)(ws + OFF_BAR))[i] = 0u;
        if (tid < 16) ((LAS unsigned*)(lds + LDS_BYTES - 64))[tid] = 0u;
        __syncthreads();
    }
#ifndef NO_PRO
    { TLW; prologue(P, lds, tid, lane, wave); }
#endif
    grid.sync();
    const XcdBarrier xbar = xcd_barrier_post((unsigned*)(ws + OFF_BAR), (volatile LAS unsigned*)(lds + LDS_BYTES - 64));
#define GRID_BAR() xcd_barrier(xbar)
    float* SSQ = (float*)(ws + OFF_SSQ);
    { TLW; prep_phase(P, lds, tid, lane, wave); }
    GRID_BAR();

    for (int l = 0; l < DEPTH; ++l) {
        const bool last = (l == DEPTH - 1);
        const void* xl_src = (l == 0) ? (const void*)P.x : (const void*)XL;
        const void* xc_src = (l == 0) ? (const void*)P.ctx : (const void*)XC;
        const float* mod_l = mod + (size_t)l * 9 * 6144;
        {
            pg8::Gemm g{H, (const bf16*)(ws + OFF_WIN) + (size_t)l * INW * DM, MT, INW, DM, DM}; pg8::StaticOrder S; S.init(MT, INW, G, bid);
            EpiInProj E{Z, cosT, sinT, SSQ, (const float*)(ws + OFF_BIN) + (size_t)l * 9 * INW};
#ifndef NO_G1
            pg8::gemm_phase<EpiInProj, pg8::StaticOrder, true, true>(lds, g, S, E);
#endif
        }
        GRID_BAR();
        {
            TLW;
            const float lam = lamv[l];
            const float lam_init = 0.8f - 0.6f * expf(-0.3f * (float)l);
            const float post = 1.f - lam_init;
            const float* gsub = P.g_sub + l * 128;
            const int n_lat = NB * 4 * (SEQ / 128);
            const int n_ctx = last ? 0 : NB * 4 * (CTXL / 128);
#ifndef NO_ATTN
            const int vcu = (G % 8 == 0) ? (bid % 8) * (G / 8) + bid / 8 : bid;
            for (int u = vcu; u < n_lat + n_ctx; u += G) {
                if (u < n_lat) { const int b = u >> 7, h = (u >> 5) & 3, qb = u & 31;
                    attn_unit(Z, MIX, b * SEQ + qb * 128, h, ML + b * CTXL, CTXL / 64, b * SEQ, SEQ / 64, lam, post, gsub, lds, tid, lane, wave);
                } else { const int v = u - n_lat, b = v >> 3, h = (v >> 1) & 3, qb = v & 1;
                    attn_unit(Z, MIX, ML + b * CTXL + qb * 128, h, ML + b * CTXL, CTXL / 64, 0, 0, lam, post, gsub, lds, tid, lane, wave); }
            }
#endif
#ifndef NO_SMALL
            const int nblk = (last ? ML : MT) / 128;
            for (int it = bid; it < nblk * 4; it += G) {
                const int tb = it >> 2, g = it & 3;
                small_item(Z, MIX, tb * 128, g, (const bf16*)(ws + OFF_WSP) + (size_t)(l * 4 + g) * 16384, P.b_sp + (l * 4 + g) * 128, P.g_v + l * 256,
                           (const bf16*)(ws + OFF_WPT) + (size_t)(l * 4 + g) * 4096, P.s_pool + l * 256, lds, tid, lane, wave);
            }
#endif
        }
        GRID_BAR();
        const int Mrows = last ? ML : MT;
        {
            pg8::Gemm g{MIX, (const bf16*)(ws + OFF_WOUT) + (size_t)l * DM * DM, Mrows, DM, DM, DM}; pg8::StaticOrder S; S.init(Mrows, DM, G, bid);
            EpiRes E{xl_src, XL, xc_src, XC, (l == 0) ? 1 : 0, mod_l + 2 * 1024, P.g_mlp + l * DM, mod_l + 4 * 1024, H, SSQ};
#ifndef NO_G2
            pg8::gemm_phase<EpiRes, pg8::StaticOrder, true, true>(lds, g, S, E);
#endif
        }
        GRID_BAR();
        {
            pg8::Gemm g{H, (const bf16*)(ws + OFF_W1) + (size_t)l * DFF * DM, Mrows, DFF, DM, DM}; pg8::StaticOrder S; S.init(Mrows, DFF, G, bid);
            EpiSqRelu E{HID, DFF, SSQ, (const float*)(ws + OFF_B1) + (size_t)l * 9 * DFF};
#ifndef NO_G3
            pg8::gemm_phase<EpiSqRelu, pg8::StaticOrder, true, true>(lds, g, S, E);
#endif
        }
        GRID_BAR();
        {
            pg8::Gemm g{HID, (const bf16*)(ws + OFF_W2) + (size_t)l * DM * DFF, ML, DM, DFF, DFF}; pg8::StaticOrder S; S.init(ML, DM, G, bid);
            EpiRes E{XL, XL, XC, XC, 0, mod_l + 5 * 1024, last ? (const float*)nullptr : P.g_mix + (l + 1) * DM, mod_l + 9 * 6144 + 1 * 1024, H, SSQ};
#ifndef NO_G4
            pg8::gemm_phase<EpiRes, pg8::StaticOrder, true, true>(lds, g, S, E);
#endif
        }
        if (!last) {
            for (int su = bid; su < 256; su += G) {
                const int tile = su >> 3, ks = su & 7;
                pg8::Gemm g{HID + (size_t)ML * DFF + ks * 512, (const bf16*)(ws + OFF_W2) + (size_t)l * DM * DFF + ks * 512, MC, DM, 512, DFF};
                OneUnit S{{tile >> 2, tile & 3}};
                EpiPartial E{P.out + (size_t)ks * MC * DM};
                pg8::gemm_phase<EpiPartial, OneUnit, false, true>(lds, g, S, E);
            }
            GRID_BAR();
            { TLW; ctx_finalize_phase(XC, (const float*)P.out, mod_l + 8 * 6144 + 5 * 1024, P.g_mix + (l + 1) * DM, mod_l + 9 * 6144 + 8 * 6144 + 1 * 1024, H, SSQ, lane, wave); }
        }
        GRID_BAR();
    }
    { TLW; final_norm_phase(XL, P.out, P.g_final, lane, wave); }
}

extern "C" void kernel_launch(void* const* d_in, const int* in_sizes, int n_in, void* d_out, int out_size, void* d_ws, size_t ws_size, hipStream_t stream) {
    static int grid_blocks = 0;
    if (grid_blocks == 0) {
        if (n_in != 23 || ws_size < WS_NEED) { fprintf(stderr, "kernel_launch: unexpected n_in %d or ws_size %zu (need %zu)\n", n_in, ws_size, (size_t)WS_NEED); grid_blocks = -1; return; }
        int dev = 0, cus = 0, per_cu = 0;
        hipGetDevice(&dev);
        hipDeviceGetAttribute(&cus, hipDeviceAttributeMultiprocessorCount, dev);
        if (hipFuncSetAttribute((const void*)fwd_megakernel, hipFuncAttributeMaxDynamicSharedMemorySize, LDS_BYTES) != hipSuccess) { fprintf(stderr, "kernel_launch: hipFuncSetAttribute failed\n"); grid_blocks = -1; return; }
        hipOccupancyMaxActiveBlocksPerMultiprocessor(&per_cu, (const void*)fwd_megakernel, NTHR, LDS_BYTES);
        if (per_cu < 1) { fprintf(stderr, "kernel_launch: occupancy query says %d blocks per CU\n", per_cu); per_cu = 1; }
        (void)hipGetLastError();
        grid_blocks = cus * per_cu;
    }
    if (grid_blocks < 0) return;
    Params p{};
    const float** pp = (const float**)&p;
    for (int i = 0; i < 23; ++i) pp[i] = (const float*)d_in[i];
    p.out = (float*)d_out; p.ws = (unsigned char*)d_ws;
    void* args[] = {&p};
    hipError_t e = hipLaunchCooperativeKernel((const void*)fwd_megakernel, dim3(grid_blocks), dim3(NTHR), args, LDS_BYTES, stream);
    if (e != hipSuccess) fprintf(stderr, "cooperative launch failed: %s (grid %d)\n", hipGetErrorString(e), grid_blocks);
}
```

```cpp
#include <hip/hip_runtime.h>
#include <hip/hip_cooperative_groups.h>
#include <cstdio>
#include <cstdint>
namespace cg = cooperative_groups;
__device__ __forceinline__ int opaque_tid() { int t = threadIdx.x; asm volatile("" : "+v"(t)); return t; }
namespace pg8 {
#define PG8_LAS __attribute__((address_space(3)))
typedef unsigned short bf16_t;
typedef short bf16x8 __attribute__((ext_vector_type(8)));
typedef float f32x4 __attribute__((ext_vector_type(4)));
typedef unsigned u32x4 __attribute__((ext_vector_type(4)));
constexpr int BM = 256, BK = 64, HALF = 128, HTB = HALF * BK * 2  , STAGE_BYTES = 8 * HTB, NXCD = 8, WGM = 8;

__host__ __device__ __forceinline__ int lds_byte(int r, int c) { const int st = (r >> 4) * 2 + (c >> 5), rr = r & 15, cc = c & 31, ob = rr * 64 + cc * 2; return st * 1024 + (ob ^ (((ob >> 9) & 1) << 5)); }
__host__ __device__ __forceinline__ void stage_rc(int b, int& R, int& C) { const int st = b / 1024, sb = b % 1024, swz = sb ^ (((sb >> 9) & 1) << 5); R = (st >> 1) * 16 + swz / 64; C = (st & 1) * 32 + (swz % 64) / 2; }
__host__ __device__ __forceinline__ int perm32(int rho) { const int n = rho >> 4, i = rho & 15; return 8 * (i >> 2) + 4 * n + (i & 3); }

struct Unit { int pm, pn; };
struct Gemm { const bf16_t* A; const bf16_t* Bt; int M, N, K, ld; };

struct StaticOrder {
    int nM, nN, nwg, G, c;
    __host__ __device__ void init(int M, int N, int G_, int c_) { nM = M / BM; nN = N / BM; nwg = nM * nN; G = G_; c = c_; }
    __host__ __device__ bool next(int i, Unit& u) const {
        const long L = (long)i * G + c; if (L >= nwg) return false;
        int wgid = (int)L; { const int q = nwg / NXCD, r = nwg % NXCD, xcd = wgid % NXCD, off = wgid / NXCD; wgid = (xcd < r ? xcd * (q + 1) : r * (q + 1) + (xcd - r) * q) + off; }
        const int nig = WGM * nN, gid = wgid / nig, fm = gid * WGM, gsz = (nM - fm) < WGM ? (nM - fm) : WGM;
        u.pm = fm + ((wgid % nig) % gsz); u.pn = (wgid % nig) / gsz; return true;
    }
    __device__ __forceinline__ void a_ready(const Unit&) const {}
    __device__ __forceinline__ void done(const Unit&) const {}
};

__device__ __forceinline__ unsigned cvt_pk_bf16(float lo, float hi) { unsigned r; asm volatile("v_cvt_pk_bf16_f32 %0, %1, %2" : "=v"(r) : "v"(lo), "v"(hi)); return r; }
typedef float f32x2 __attribute__((ext_vector_type(2)));
__device__ __forceinline__ f32x2 gelu_pk(f32x2 v) {
    const f32x2 av = __builtin_elementwise_abs(v), d = av * 0.2316418882f + 1.0f;
    f32x2 t; t.x = __builtin_amdgcn_rcpf(d.x); t.y = __builtin_amdgcn_rcpf(d.y);
    f32x2 q = t * 0.5307027145f + (-0.7265760135f); q = q * t + 0.7107068705f; q = q * t + (-0.142248368f); q = q * t + 0.127414796f; q = q * t;
    const f32x2 s = (v * v) * (-0.72134752044f);
    f32x2 e; e.x = __builtin_amdgcn_exp2f(s.x); e.y = __builtin_amdgcn_exp2f(s.y);
    const f32x2 m = v * (q * e), r = v - m;
    f32x2 o; o.x = v.x < 0.f ? m.x : r.x; o.y = v.y < 0.f ? m.y : r.y; return o;
}

template <int ACT  > struct EpiBf16 {
    static constexpr bool PERM = true, AFTER_DRAIN = false; static_assert(ACT == 0 || ACT == 1, "EpiBf16: ACT is 0 (none) or 1 (gelu_pk)");
    bf16_t* O; int ldc; const float* bias; int split_cols; size_t split_stride; float scale0;
    __device__ __forceinline__ void operator()(const f32x4 (&acc)[2][2][4][2], const Unit& u, int wr, int wc, int fr, int fq) const {
        const int row0 = u.pm * BM + wr * 64 + fr; int colt = u.pn * BM; bf16_t* base = O;
        float sc = 1.f; if (split_cols) { const int t = colt / split_cols; base += (size_t)t * split_stride; colt -= t * split_cols; if (t == 0) sc = scale0; }
        const int col0 = colt + wc * 32 + 8 * fq, bcol0 = u.pn * BM + wc * 32 + 8 * fq;
        f32x4 bv[2][2];
#pragma unroll
        for (int bj = 0; bj < 2; ++bj)
#pragma unroll
            for (int n = 0; n < 2; ++n) bv[bj][n] = bias ? *(const f32x4*)(bias + bcol0 + bj * HALF + 4 * n) : (f32x4){0.f, 0.f, 0.f, 0.f};
#pragma unroll
        for (int ai = 0; ai < 2; ++ai)
#pragma unroll
            for (int m = 0; m < 4; ++m) { bf16_t* rowp = base + (size_t)(row0 + ai * HALF + m * 16) * ldc + col0;
#pragma unroll
                for (int bj = 0; bj < 2; ++bj) { f32x4 v0 = acc[ai][bj][m][0] + bv[bj][0], v1 = acc[ai][bj][m][1] + bv[bj][1];
                    if (ACT == 1) { f32x2 a = gelu_pk((f32x2){v0[0], v0[1]}), b = gelu_pk((f32x2){v0[2], v0[3]}), c = gelu_pk((f32x2){v1[0], v1[1]}), d = gelu_pk((f32x2){v1[2], v1[3]});
                        v0 = (f32x4){a.x, a.y, b.x, b.y}; v1 = (f32x4){c.x, c.y, d.x, d.y}; }
                    v0 = v0 * sc; v1 = v1 * sc; u32x4 w; w.x = cvt_pk_bf16(v0[0], v0[1]); w.y = cvt_pk_bf16(v0[2], v0[3]); w.z = cvt_pk_bf16(v1[0], v1[1]); w.w = cvt_pk_bf16(v1[2], v1[3]);
                    *(u32x4*)(rowp + bj * HALF) = w; } }
    }
};
template <class Epi, class Sched, bool ALIGN_EPI = false, bool SP2 = false>
__device__ __forceinline__ void gemm_phase(PG8_LAS unsigned char* lds, const Gemm g, const Sched& S, const Epi& E) {
    const int tid = opaque_tid(), wid = __builtin_amdgcn_readfirstlane(tid >> 6), lane = tid & 63, wr = wid >> 2, wc = wid & 3, fr = lane & 15, fq = lane >> 4;
    const int K = g.K, nt = K / BK;
    unsigned voffA[2], voffB[2];
#pragma unroll
    for (int i = 0; i < 2; ++i) { int R, C; stage_rc(tid * 16 + i * 8192, R, C); const int Rb = Epi::PERM ? ((R & ~31) + perm32(R & 31)) : R;
        voffA[i] = (unsigned)(R * g.ld + C) * 2u; voffB[i] = (unsigned)(Rb * g.ld + C) * 2u; }
    const size_t kstep = (size_t)(BK * 2);
    const size_t hstep = (size_t)HALF * g.ld * 2;
    const size_t tstep = 2 * hstep;
    const unsigned ldsw = (unsigned)wid * 1024u;
    const int aoff = lds_byte(wr * 64 + fr, fq * 8), boff = lds_byte(wc * 32 + fr, fq * 8);
#define PG8_SA(b, h) (((b) * 2 + (h)) * HTB)
#define PG8_SB(b, h) ((4 + (b) * 2 + (h)) * HTB)
#define PG8_STAGE(bufoff, gbase, voff) do { _Pragma("unroll") for (int _i = 0; _i < 2; ++_i) \
        __builtin_amdgcn_global_load_lds((const unsigned*)((const char*)(gbase) + (voff)[_i]), (PG8_LAS unsigned*)(lds + (bufoff) + ldsw + _i * 8192), 16, 0, 0); } while (0)
#define PG8_LDA(dst, b, h) do { _Pragma("unroll") for (int m = 0; m < 4; ++m) _Pragma("unroll") for (int k = 0; k < 2; ++k) dst[m][k] = *(const PG8_LAS bf16x8*)(lds + PG8_SA(b, h) + aoff + m * 2048 + k * 1024); } while (0)
#define PG8_LDB(dst, b, h) do { _Pragma("unroll") for (int n = 0; n < 2; ++n) _Pragma("unroll") for (int k = 0; k < 2; ++k) dst[n][k] = *(const PG8_LAS bf16x8*)(lds + PG8_SB(b, h) + boff + n * 2048 + k * 1024); } while (0)
#define PG8_MMA(ai, bj, At, Bt) do { __builtin_amdgcn_s_setprio(1); _Pragma("unroll") for (int m = 0; m < 4; ++m) _Pragma("unroll") for (int n = 0; n < 2; ++n) _Pragma("unroll") for (int k = 0; k < 2; ++k) \
        acc[ai][bj][m][n] = __builtin_amdgcn_mfma_f32_16x16x32_bf16(Bt[n][k], At[m][k], acc[ai][bj][m][n], 0, 0, 0); __builtin_amdgcn_s_setprio(0); } while (0)
#define PG8_WAIT_V(n) asm volatile("s_waitcnt vmcnt(" #n ")" ::: "memory")
#define PG8_WAIT_L(n) asm volatile("s_waitcnt lgkmcnt(" #n ")" ::: "memory")
#define PG8_BAR __builtin_amdgcn_s_barrier()
#define PG8_SCHED __builtin_amdgcn_sched_barrier(0)
    Unit cur, nxt; int ui = 0;
    if (!S.next(0, cur)) return;
    f32x4 acc[2][2][4][2];
#pragma unroll
    for (int a = 0; a < 2; ++a)
#pragma unroll
        for (int b = 0; b < 2; ++b)
#pragma unroll
            for (int m = 0; m < 4; ++m)
#pragma unroll
                for (int n = 0; n < 2; ++n) acc[a][b][m][n] = (f32x4){0.f, 0.f, 0.f, 0.f};
    bf16x8 At[4][2], B0[2][2], B1[2][2];
    const char* cA = (const char*)g.A + (size_t)cur.pm * tstep; const char* cB = (const char*)g.Bt + (size_t)cur.pn * tstep;
    S.a_ready(cur);
    if constexpr (SP2) {
        PG8_STAGE(PG8_SB(0, 0), cB, voffB); PG8_STAGE(PG8_SB(0, 1), cB + hstep, voffB); PG8_STAGE(PG8_SA(0, 0), cA, voffA); PG8_STAGE(PG8_SA(0, 1), cA + hstep, voffA);
        if (wr == 1) PG8_BAR;
        PG8_WAIT_V(2); PG8_BAR;
        PG8_STAGE(PG8_SB(1, 0), cB + kstep, voffB); PG8_STAGE(PG8_SA(1, 0), cA + kstep, voffA); PG8_STAGE(PG8_SB(1, 1), cB + hstep + kstep, voffB);
        PG8_WAIT_V(6); PG8_BAR;
    } else {
        PG8_STAGE(PG8_SB(0, 0), cB, voffB); PG8_STAGE(PG8_SA(0, 0), cA, voffA); PG8_STAGE(PG8_SB(0, 1), cB + hstep, voffB); PG8_STAGE(PG8_SA(0, 1), cA + hstep, voffA);
        if (wr == 1) PG8_BAR;
        PG8_WAIT_V(4); PG8_BAR;
        PG8_STAGE(PG8_SB(1, 0), cB + kstep, voffB); PG8_STAGE(PG8_SA(1, 0), cA + kstep, voffA); PG8_STAGE(PG8_SB(1, 1), cB + hstep + kstep, voffB);
        PG8_WAIT_V(6); PG8_BAR;
    }
    for (;;) {
        const bool has_next = S.next(ui + 1, nxt);
        const char* nA = has_next ? (const char*)g.A + (size_t)nxt.pm * tstep : cA; const char* nB = has_next ? (const char*)g.Bt + (size_t)nxt.pn * tstep : cB;
        for (int t = 0; t < nt; t += 2) {
            const bool last = (t == nt - 2);
            const char* a1 = cA + (size_t)(t + 1) * kstep;
            const char* a2 = last ? nA : cA + (size_t)(t + 2) * kstep; const char* b2 = last ? nB : cB + (size_t)(t + 2) * kstep;
            const char* a3 = a2 + kstep; const char* b3 = b2 + kstep;
            if (last && has_next) S.a_ready(nxt);
            if constexpr (SP2) {
            PG8_LDB(B0, 0, 0); PG8_LDB(B1, 0, 1); PG8_SCHED; PG8_LDA(At, 0, 0); PG8_STAGE(PG8_SA(1, 1), a1 + hstep, voffA);
            PG8_WAIT_V(8); PG8_WAIT_L(0); PG8_BAR; PG8_MMA(0, 0, At, B0); PG8_MMA(0, 1, At, B1); PG8_BAR; PG8_SCHED;
            PG8_LDA(At, 0, 1); PG8_STAGE(PG8_SB(0, 0), b2, voffB); PG8_STAGE(PG8_SB(0, 1), b2 + hstep, voffB); PG8_STAGE(PG8_SA(0, 0), a2, voffA);
            PG8_WAIT_V(8); PG8_WAIT_L(0); PG8_BAR; PG8_MMA(1, 0, At, B0); PG8_MMA(1, 1, At, B1); PG8_BAR; PG8_SCHED;
            PG8_LDB(B0, 1, 0); PG8_LDB(B1, 1, 1); PG8_SCHED; PG8_LDA(At, 1, 0); PG8_STAGE(PG8_SA(0, 1), a2 + hstep, voffA);
            PG8_WAIT_V(8); PG8_WAIT_L(0); PG8_BAR; PG8_MMA(0, 0, At, B0); PG8_MMA(0, 1, At, B1); PG8_BAR; PG8_SCHED;
            PG8_LDA(At, 1, 1); PG8_STAGE(PG8_SB(1, 0), b3, voffB); PG8_STAGE(PG8_SB(1, 1), b3 + hstep, voffB); PG8_STAGE(PG8_SA(1, 0), a3, voffA);
            PG8_WAIT_V(8); PG8_WAIT_L(0); PG8_BAR; PG8_MMA(1, 0, At, B0); PG8_MMA(1, 1, At, B1); PG8_BAR; PG8_SCHED;
            } else {
            PG8_LDB(B0, 0, 0); PG8_SCHED; PG8_LDA(At, 0, 0); PG8_STAGE(PG8_SA(1, 1), a1 + hstep, voffA);
            PG8_WAIT_L(8); PG8_BAR; PG8_WAIT_L(0); PG8_MMA(0, 0, At, B0); PG8_BAR; PG8_SCHED;
            PG8_LDB(B1, 0, 1); PG8_STAGE(PG8_SB(0, 0), b2, voffB);
            PG8_BAR; PG8_WAIT_L(0); PG8_MMA(0, 1, At, B1); PG8_BAR;
            PG8_LDA(At, 0, 1); PG8_STAGE(PG8_SA(0, 0), a2, voffA);
            PG8_BAR; PG8_WAIT_L(0); PG8_MMA(1, 0, At, B0); PG8_BAR; PG8_SCHED;
            PG8_STAGE(PG8_SB(0, 1), b2 + hstep, voffB);
            PG8_WAIT_V(6); PG8_BAR; PG8_MMA(1, 1, At, B1); PG8_BAR;
            PG8_LDB(B0, 1, 0); PG8_SCHED; PG8_LDA(At, 1, 0); PG8_STAGE(PG8_SA(0, 1), a2 + hstep, voffA);
            PG8_WAIT_L(8); PG8_BAR; PG8_WAIT_L(0); PG8_MMA(0, 0, At, B0); PG8_BAR; PG8_SCHED;
            PG8_LDB(B1, 1, 1); PG8_STAGE(PG8_SB(1, 0), b3, voffB);
            PG8_BAR; PG8_WAIT_L(0); PG8_MMA(0, 1, At, B1); PG8_BAR;
            PG8_LDA(At, 1, 1); PG8_STAGE(PG8_SA(1, 0), a3, voffA);
            PG8_BAR; PG8_WAIT_L(0); PG8_MMA(1, 0, At, B0); PG8_BAR; PG8_SCHED;
            PG8_STAGE(PG8_SB(1, 1), b3 + hstep, voffB);
            PG8_WAIT_V(6); PG8_BAR; PG8_MMA(1, 1, At, B1); PG8_BAR;
            }
        }
        if constexpr (ALIGN_EPI) { if (wr == 0) PG8_BAR; }
        if constexpr (!Epi::AFTER_DRAIN) { E(acc, cur, wr, wc, fr, fq); S.done(cur); }
        if (!has_next) break;
#pragma unroll
        for (int a = 0; a < 2; ++a)
#pragma unroll
            for (int b = 0; b < 2; ++b)
#pragma unroll
                for (int m = 0; m < 4; ++m)
#pragma unroll
                    for (int n = 0; n < 2; ++n) acc[a][b][m][n] = (f32x4){0.f, 0.f, 0.f, 0.f};
        cur = nxt; cA = nA; cB = nB; ++ui;
        if constexpr (ALIGN_EPI) { if (wr == 1) PG8_BAR; }
    }
    PG8_WAIT_V(0);
    if constexpr (!ALIGN_EPI) { if (wr == 0) PG8_BAR; }
    PG8_BAR;
    if constexpr (Epi::AFTER_DRAIN) { E.fused(acc, cur, wr, wc, fr, fq, lds, wid, lane); S.done(cur); }
#undef PG8_SA
#undef PG8_SB
#undef PG8_STAGE
#undef PG8_LDA
#undef PG8_LDB
#undef PG8_MMA
#undef PG8_WAIT_V
#undef PG8_WAIT_L
#undef PG8_BAR
#undef PG8_SCHED
}
}

constexpr int DM = 1024, NB = 8, SEQ = 4096, DEPTH = 4, CTXL = 256, INW = 2304, DFF = 4096;
constexpr int ML = NB * SEQ;
constexpr int MC = NB * CTXL;
constexpr int MT = ML + MC;
constexpr float EPS = 1e-6f;
constexpr float QSCALE = 0.125f * 1.4426950408889634f;

constexpr size_t MiB = 1u << 20;
constexpr size_t OFF_MOD = 0;
constexpr size_t OFF_TAB = 1 * MiB;
constexpr size_t OFF_BAR = 1 * MiB + 16 * 1024;
constexpr size_t OFF_WSP = 1 * MiB + 64 * 1024;
constexpr size_t OFF_WPT = OFF_WSP + 512 * 1024;
constexpr size_t OFF_WIN = 2 * MiB;
constexpr size_t OFF_WOUT = 20 * MiB;
constexpr size_t OFF_W1 = 28 * MiB;
constexpr size_t OFF_W2 = 60 * MiB;
constexpr size_t OFF_XC = 92 * MiB;
constexpr size_t OFF_H = 100 * MiB;
constexpr size_t OFF_Z = 168 * MiB;
constexpr size_t OFF_MIX = 321 * MiB;
constexpr size_t OFF_HID = 168 * MiB;
constexpr size_t OFF_SSQ = 440 * MiB;
constexpr size_t OFF_BIN = 443 * MiB;
constexpr size_t OFF_B1 = 444 * MiB;
constexpr size_t OFF_XL = 445 * MiB;
constexpr size_t WS_NEED = 509 * MiB;

constexpr int LDS_BYTES = 147456;
constexpr int NTHR = 512;

#define LAS __attribute__((address_space(3)))
typedef unsigned short bf16;
typedef short bf16x8 __attribute__((ext_vector_type(8)));
typedef float f32x4 __attribute__((ext_vector_type(4)));
typedef float f32x16 __attribute__((ext_vector_type(16)));
typedef unsigned u32x4 __attribute__((ext_vector_type(4)));
typedef unsigned u32x2 __attribute__((ext_vector_type(2)));
typedef short s16x4 __attribute__((ext_vector_type(4)));
typedef float f32x2_t __attribute__((ext_vector_type(2)));
typedef __bf16 bf16x2_t __attribute__((ext_vector_type(2)));
typedef _Float16 h16x4 __attribute__((ext_vector_type(4)));

__device__ __forceinline__ unsigned cvtpk(float lo, float hi) { f32x2_t v = {lo, hi}; bf16x2_t b = __builtin_convertvector(v, bf16x2_t); return __builtin_bit_cast(unsigned, b); }
__device__ __forceinline__ bf16 f2bf(float f) { return (bf16)(cvtpk(f, 0.f) & 0xffffu); }
__device__ __forceinline__ float bf2f(unsigned b) { return __uint_as_float(b << 16); }
__device__ __forceinline__ float bflo(unsigned w) { return __uint_as_float(w << 16); }
__device__ __forceinline__ float bfhi(unsigned w) { return __uint_as_float(w & 0xffff0000u); }
__device__ __forceinline__ int crow(int r, int hi) { return (r & 3) + 8 * (r >> 2) + 4 * hi; }
__device__ __forceinline__ float wave_sum(float v) {
#pragma unroll
    for (int o = 1; o < 64; o <<= 1) v += __shfl_xor(v, o);
    return v;
}

__host__ __device__ __forceinline__ int rope_perm32(int j) { return 8 * ((j & 15) >> 2) + 4 * (j >> 4) + (j & 3); }
struct Params {
    const float *x, *c, *ctx, *c_ctx, *w_ada, *b_ada, *g_mix, *g_mlp, *w_in, *lq1, *lk1, *lq2, *lk2, *g_sub, *g_v, *w_sp, *b_sp, *w_pool, *s_pool, *w_out, *w1, *w2, *g_final;
    float* out; unsigned char* ws;
};

struct EpiInProj {
    static constexpr bool PERM = true, AFTER_DRAIN = false;
    bf16* Z; const float* cosT; const float* sinT; const float* ssq; const float* bias;
    __device__ __forceinline__ void operator()(const pg8::f32x4 (&acc)[2][2][4][2], const pg8::Unit& u, int wr, int wc, int fr, int fq) const {
        const bool rope = (u.pn < 4) && (u.pm < ML / 256);
        const float sc = (u.pn < 2) ? QSCALE : 1.f;
        const int row0 = u.pm * 256 + wr * 64 + fr, col0 = u.pn * 256 + wc * 32 + 8 * fq;
        const float* bp = bias + (size_t)((u.pm < ML / 256) ? (u.pm >> 4) : 8) * INW + col0;
        f32x4 bv[2][2];
#pragma unroll
        for (int bj = 0; bj < 2; ++bj)
#pragma unroll
            for (int n = 0; n < 2; ++n) bv[bj][n] = *(const f32x4*)(bp + bj * 128 + n * 4);
#pragma unroll
        for (int ai = 0; ai < 2; ++ai)
#pragma unroll
            for (int m = 0; m < 4; ++m) {
                const int row = row0 + ai * 128 + m * 16;
                float rstd;
                { const f32x4* sp = (const f32x4*)(ssq + (size_t)row * 16); const f32x4 a = sp[0] + sp[1] + sp[2] + sp[3]; rstd = rsqrtf(((a[0] + a[1]) + (a[2] + a[3])) * (1.f / DM) + EPS); }
                f32x4 cs = {1.f, 1.f, 1.f, 1.f}, sn = {0.f, 0.f, 0.f, 0.f};
                if (rope) { const int pos = (wc & 1) ? (row & 63) : ((row >> 6) & 63); cs = *(const f32x4*)(cosT + pos * 16 + 4 * fq); sn = *(const f32x4*)(sinT + pos * 16 + 4 * fq); }
                bf16* rowp = Z + (size_t)row * INW + col0;
#pragma unroll
                for (int bj = 0; bj < 2; ++bj) {
                    const f32x4 x1 = acc[ai][bj][m][0] * rstd + bv[bj][0], x2 = acc[ai][bj][m][1] * rstd + bv[bj][1];
                    const f32x4 o1 = (x1 * cs - x2 * sn) * sc, o2 = (x2 * cs + x1 * sn) * sc;
                    *(u32x4*)(rowp + bj * 128) = (u32x4){cvtpk(o1[0], o1[1]), cvtpk(o1[2], o1[3]), cvtpk(o2[0], o2[1]), cvtpk(o2[2], o2[3])};
                }
            }
    }
};
struct EpiSqRelu {
    static constexpr bool PERM = true, AFTER_DRAIN = false;
    bf16* O; int ldc; const float* ssq; const float* bias;
    __device__ __forceinline__ void operator()(const pg8::f32x4 (&acc)[2][2][4][2], const pg8::Unit& u, int wr, int wc, int fr, int fq) const {
        const int row0 = u.pm * 256 + wr * 64 + fr, col0 = u.pn * 256 + wc * 32 + 8 * fq;
        const float* bp = bias + (size_t)((u.pm < ML / 256) ? (u.pm >> 4) : 8) * DFF + col0;
        f32x4 bv[2][2];
#pragma unroll
        for (int bj = 0; bj < 2; ++bj)
#pragma unroll
            for (int n = 0; n < 2; ++n) bv[bj][n] = *(const f32x4*)(bp + bj * 128 + n * 4);
#pragma unroll
        for (int ai = 0; ai < 2; ++ai)
#pragma unroll
            for (int m = 0; m < 4; ++m) { const int row = row0 + ai * 128 + m * 16; bf16* rowp = O + (size_t)row * ldc + col0;
                float rstd;
                { const f32x4* sp = (const f32x4*)(ssq + (size_t)row * 16); const f32x4 a = sp[0] + sp[1] + sp[2] + sp[3]; rstd = rsqrtf(((a[0] + a[1]) + (a[2] + a[3])) * (1.f / DM) + EPS); }
#pragma unroll
                for (int bj = 0; bj < 2; ++bj) {
                    f32x4 v0 = acc[ai][bj][m][0] * rstd + bv[bj][0], v1 = acc[ai][bj][m][1] * rstd + bv[bj][1];
#pragma unroll
                    for (int e = 0; e < 4; ++e) { const float a = fmaxf(v0[e], 0.f), b = fmaxf(v1[e], 0.f); v0[e] = a * a; v1[e] = b * b; }
                    u32x4 w; w.x = cvtpk(v0[0], v0[1]); w.y = cvtpk(v0[2], v0[3]); w.z = cvtpk(v1[0], v1[1]); w.w = cvtpk(v1[2], v1[3]);
                    *(u32x4*)(rowp + bj * 128) = w; } }
    }
};
#ifndef EPIRES_FENCE
#define EPIRES_FENCE
#endif
struct EpiRes {
    static constexpr bool PERM = true, AFTER_DRAIN = false;
    const void* srcL; _Float16* dstL; const void* srcC; _Float16* dstC; int src_f32; const float* gate;
    const float* nxt_g; const float* nxt_sc; bf16* XG; float* ssq;
    __device__ __forceinline__ void operator()(const pg8::f32x4 (&acc)[2][2][4][2], const pg8::Unit& u, int wr, int wc, int fr, int fq) const {
        const bool lat = u.pm < ML / 256;
        const int bidx = lat ? (u.pm >> 4) : 8;
        const float* g = gate + (size_t)bidx * 6144;
        const size_t rbase = lat ? 0 : (size_t)ML * DM;
        const float* src32 = (const float*)(lat ? srcL : srcC) - rbase; const _Float16* src16 = (const _Float16*)(lat ? srcL : srcC) - rbase;
        _Float16* dst = (lat ? dstL : dstC) - rbase;
        const int row0 = u.pm * 256 + wr * 64 + fr, col0 = u.pn * 256 + wc * 32 + 8 * fq;
        const bool has_next = nxt_g != nullptr;
        float ss[2][4];
#pragma unroll
        for (int ai = 0; ai < 2; ++ai)
#pragma unroll
            for (int m = 0; m < 4; ++m) ss[ai][m] = 0.f;
#pragma unroll
        for (int bj = 0; bj < 2; ++bj) { const int col = col0 + bj * 128;
            const f32x4 gv0 = *(const f32x4*)(g + col), gv1 = *(const f32x4*)(g + col + 4);
            f32x4 gm0 = {0.f, 0.f, 0.f, 0.f}, gm1 = {0.f, 0.f, 0.f, 0.f};
            if (has_next) { const float* sc = nxt_sc + (size_t)bidx * 6144 + col;
                gm0 = *(const f32x4*)(nxt_g + col) * (*(const f32x4*)sc + 1.f); gm1 = *(const f32x4*)(nxt_g + col + 4) * (*(const f32x4*)(sc + 4) + 1.f); }
#pragma unroll
            for (int ai = 0; ai < 2; ++ai)
#pragma unroll
                for (int m = 0; m < 4; ++m) { const size_t off = (size_t)(row0 + ai * 128 + m * 16) * DM + col;
                    f32x4 x0, x1;
                    if (src_f32) { x0 = *(const f32x4*)(src32 + off); x1 = *(const f32x4*)(src32 + off + 4); }
                    else { const u32x4 raw = *(const u32x4*)(src16 + off); const u32x2 lo = {raw[0], raw[1]}, hi2 = {raw[2], raw[3]};
                        x0 = __builtin_convertvector(__builtin_bit_cast(h16x4, lo), f32x4); x1 = __builtin_convertvector(__builtin_bit_cast(h16x4, hi2), f32x4); }
                    const f32x4 n0 = x0 + gv0 * acc[ai][bj][m][0], n1 = x1 + gv1 * acc[ai][bj][m][1];
                    { const u32x2 lo = __builtin_bit_cast(u32x2, __builtin_convertvector(n0, h16x4)), hi2 = __builtin_bit_cast(u32x2, __builtin_convertvector(n1, h16x4));
                      *(u32x4*)(dst + off) = (u32x4){lo[0], lo[1], hi2[0], hi2[1]}; }
                    if (has_next) { ss[ai][m] += ((n0[0] * n0[0] + n0[1] * n0[1]) + (n0[2] * n0[2] + n0[3] * n0[3])) + ((n1[0] * n1[0] + n1[1] * n1[1]) + (n1[2] * n1[2] + n1[3] * n1[3]));
                        const f32x4 y0 = n0 * gm0, y1 = n1 * gm1;
                        *(u32x4*)(XG + off) = (u32x4){cvtpk(y0[0], y0[1]), cvtpk(y0[2], y0[3]), cvtpk(y1[0], y1[1]), cvtpk(y1[2], y1[3])}; } }
        }
        if (has_next) {
#pragma unroll
            for (int ai = 0; ai < 2; ++ai)
#pragma unroll
                for (int m = 0; m < 4; ++m) { float v = ss[ai][m]; v += __shfl_xor(v, 16); v += __shfl_xor(v, 32);
                    if (fq == 0) ssq[(size_t)(row0 + ai * 128 + m * 16) * 16 + u.pn * 4 + wc] = v; }
        }
    }
};

struct EpiPartial {
    static constexpr bool PERM = false, AFTER_DRAIN = false;
    float* PART;
    __device__ __forceinline__ void operator()(const pg8::f32x4 (&acc)[2][2][4][2], const pg8::Unit& u, int wr, int wc, int fr, int fq) const {
        const int row0 = u.pm * 256 + wr * 64 + fr, col0 = u.pn * 256 + wc * 32 + 4 * fq;
#pragma unroll
        for (int ai = 0; ai < 2; ++ai)
#pragma unroll
            for (int m = 0; m < 4; ++m)
#pragma unroll
                for (int bj = 0; bj < 2; ++bj)
#pragma unroll
                    for (int n = 0; n < 2; ++n) *(f32x4*)(PART + (size_t)(row0 + ai * 128 + m * 16) * DM + col0 + bj * 128 + n * 16) = acc[ai][bj][m][n];
    }
};
struct OneUnit {
    pg8::Unit u0;
    __device__ __forceinline__ bool next(int i, pg8::Unit& u) const { if (i) return false; u = u0; return true; }
    __device__ __forceinline__ void a_ready(const pg8::Unit&) const {}
    __device__ __forceinline__ void done(const pg8::Unit&) const {}
};
__device__ __forceinline__ void ctx_finalize_phase(_Float16* XC, const float* PART, const float* gate8, const float* nxt_g, const float* nxt_sc8, bf16* H, float* ssq, int lane, int wave) {
    const int gw = blockIdx.x * 8 + wave, NGW = gridDim.x * 8;
    for (int row = gw; row < MC; row += NGW) {
        h16x4* xr = (h16x4*)(XC + (size_t)row * DM) + lane;
        f32x4 v[4]; float s = 0.f;
#pragma unroll
        for (int j = 0; j < 4; ++j) {
            f32x4 a = {0.f, 0.f, 0.f, 0.f};
#pragma unroll
            for (int ks = 0; ks < 8; ++ks) a += *((const f32x4*)(PART + ((size_t)ks * MC + row) * DM) + lane + 64 * j);
            v[j] = __builtin_convertvector(xr[64 * j], f32x4) + *((const f32x4*)gate8 + lane + 64 * j) * a; xr[64 * j] = __builtin_convertvector(v[j], h16x4);
            s += (v[j][0] * v[j][0] + v[j][1] * v[j][1]) + (v[j][2] * v[j][2] + v[j][3] * v[j][3]); }
        const float tot = wave_sum(s);
        u32x2* o = (u32x2*)(H + (size_t)(ML + row) * DM) + lane;
#pragma unroll
        for (int j = 0; j < 4; ++j) { const f32x4 y = v[j] * *((const f32x4*)nxt_g + lane + 64 * j) * (*((const f32x4*)nxt_sc8 + lane + 64 * j) + 1.f);
            u32x2 w; w.x = cvtpk(y[0], y[1]); w.y = cvtpk(y[2], y[3]); o[64 * j] = w; }
        if (lane < 16) ssq[(size_t)(ML + row) * 16 + lane] = (lane == 0) ? tot : 0.f;
    }
}

__device__ __forceinline__ void transpose_item(const float* W, int K, int N, bf16* WT, LAS float* scr, int item, int lane, int perm_lim = 0) {
    const int nblk = N / 32, kb = item / nblk, nb = item % nblk, k0 = 64 * kb, n0 = 32 * nb;
#pragma unroll 8
    for (int i = 0; i < 32; ++i) { const int kk = 2 * i + (lane >> 5); scr[kk * 33 + (lane & 31)] = W[(size_t)(k0 + kk) * N + n0 + (lane & 31)]; }
    asm volatile("s_waitcnt lgkmcnt(0)" ::: "memory");
    const int c = lane & 7;
#pragma unroll
    for (int j = 0; j < 4; ++j) { const int n = (lane >> 3) + 8 * j; const LAS float* s = scr + (8 * c) * 33 + n;
        u32x4 o; o.x = cvtpk(s[0 * 33], s[1 * 33]); o.y = cvtpk(s[2 * 33], s[3 * 33]); o.z = cvtpk(s[4 * 33], s[5 * 33]); o.w = cvtpk(s[6 * 33], s[7 * 33]);
        const int nn = (n0 < perm_lim) ? rope_perm32(n) : n;
        *(u32x4*)(WT + (size_t)(n0 + nn) * K + k0 + 8 * c) = o; }
    asm volatile("s_waitcnt lgkmcnt(0)" ::: "memory");
}

__device__ __forceinline__ void gemv9_item(const float* Wc, int ldw, const LAS float* vec, LAS float* red, float* outc, int ldo, const float* addb, int tid, int lane, int wave, bool perm = false);
__device__ __forceinline__ void prologue(const Params& P, LAS unsigned char* lds, int tid, int lane, int wave) {
    unsigned char* ws = P.ws;
    const int G = gridDim.x, gw = blockIdx.x * 8 + wave, NGW = G * 8;
    {
        LAS float* scr = (LAS float*)(lds + wave * 16384);
        constexpr int I_IN = (DM / 64) * (INW / 32), I_OUT = (DM / 64) * (DM / 32), I_1 = (DM / 64) * (DFF / 32), I_2 = (DFF / 64) * (DM / 32), I_P = 2;
        constexpr int PER_L = I_IN + I_OUT + I_1 + I_2 + 4 * I_P;
        for (int it = gw; it < DEPTH * PER_L; it += NGW) {
            const int l = it / PER_L; int r = it % PER_L;
            if (r < I_IN) { transpose_item(P.w_in + (size_t)l * DM * INW, DM, INW, (bf16*)(ws + OFF_WIN) + (size_t)l * INW * DM, scr, r, lane, 1024); continue; } r -= I_IN;
            if (r < I_OUT) { transpose_item(P.w_out + (size_t)l * DM * DM, DM, DM, (bf16*)(ws + OFF_WOUT) + (size_t)l * DM * DM, scr, r, lane); continue; } r -= I_OUT;
            if (r < I_1) { transpose_item(P.w1 + (size_t)l * DM * DFF, DM, DFF, (bf16*)(ws + OFF_W1) + (size_t)l * DFF * DM, scr, r, lane); continue; } r -= I_1;
            if (r < I_2) { transpose_item(P.w2 + (size_t)l * DFF * DM, DFF, DM, (bf16*)(ws + OFF_W2) + (size_t)l * DM * DFF, scr, r, lane); continue; } r -= I_2;
            const int g = r / I_P; r %= I_P;
            transpose_item(P.w_pool + (size_t)(l * 4 + g) * 4096, 64, 64, (bf16*)(ws + OFF_WPT) + (size_t)(l * 4 + g) * 4096, scr, r, lane);
        }
    }
    {
        bf16* wsp = (bf16*)(ws + OFF_WSP);
        for (int i = blockIdx.x * NTHR + tid; i < DEPTH * 4 * 128 * 128 / 4; i += G * NTHR) {
            const f32x4 v = *(const f32x4*)(P.w_sp + (size_t)i * 4); u32x2 o; o.x = cvtpk(v[0], v[1]); o.y = cvtpk(v[2], v[3]); *(u32x2*)(wsp + (size_t)i * 4) = o; }
    }
    if (blockIdx.x == (unsigned)(G - 1)) {
        float* cosT = (float*)(ws + OFF_TAB); float* sinT = cosT + 1024; float* lam = cosT + 2048;
        for (int idx = tid; idx < 1024; idx += NTHR) {
            const int pos = idx >> 4, i = idx & 15;
            const float inv = __builtin_amdgcn_exp2f(-(float)i * (13.287712379549449f / 16.0f));
            const double rev0 = (double)pos * (double)inv * 0.15915494309189535; const float rev = (float)(rev0 - floor(rev0));
            cosT[idx] = __builtin_amdgcn_cosf(rev); sinT[idx] = __builtin_amdgcn_sinf(rev);
        }
        if (tid < DEPTH) {
            const int l = tid; float s1 = 0.f, s2 = 0.f;
            for (int i = 0; i < 64; ++i) { s1 += P.lq1[l * 64 + i] * P.lk1[l * 64 + i]; s2 += P.lq2[l * 64 + i] * P.lk2[l * 64 + i]; }
            const float lam_init = 0.8f - 0.6f * expf(-0.3f * (float)l);
            lam[l] = expf(s1) - expf(s2) + lam_init;
        }
    }
    __syncthreads();
    {
        LAS float* vec = (LAS float*)lds; LAS float* red = (LAS float*)(lds + 1024 * 12 * 4);
        for (int i = tid; i < 9 * 1024; i += NTHR) { const int j = i >> 10, k = i & 1023; const float v = (j < 8) ? P.c[j * 1024 + k] : P.c_ctx[k]; vec[k * 12 + j] = v / (1.f + __expf(-v)); }
        __syncthreads();
        float* mod = (float*)(ws + OFF_MOD);
        for (int it = blockIdx.x; it < DEPTH * 96; it += G) {
            const int l = it / 96, n0 = (it % 96) * 64;
            gemv9_item(P.w_ada + (size_t)l * DM * 6144 + n0, 6144, vec, red, mod + (size_t)l * 9 * 6144 + n0, 6144, P.b_ada + l * 6144 + n0, tid, lane, wave);
        }
    }
}

__device__ __forceinline__ void gemv9_item(const float* Wc  , int ldw, const LAS float* vec, LAS float* red, float* outc  , int ldo, const float* addb  , int tid, int lane, int wave, bool perm) {
    float a[9];
#pragma unroll
    for (int j = 0; j < 9; ++j) a[j] = 0.f;
    const int k0 = wave * 128; const float* W = Wc + lane;
#pragma unroll 16
    for (int k = 0; k < 128; ++k) { const float w = W[(size_t)(k0 + k) * ldw];
        const LAS f32x4* vp = (const LAS f32x4*)(vec + (k0 + k) * 12); const f32x4 v0 = vp[0], v1 = vp[1], v2 = vp[2];
        a[0] += v0[0] * w; a[1] += v0[1] * w; a[2] += v0[2] * w; a[3] += v0[3] * w; a[4] += v1[0] * w; a[5] += v1[1] * w; a[6] += v1[2] * w; a[7] += v1[3] * w; a[8] += v2[0] * w; }
#pragma unroll
    for (int j = 0; j < 9; ++j) red[(wave * 9 + j) * 64 + lane] = a[j];
    __syncthreads();
    for (int idx = tid; idx < 576; idx += NTHR) { const int j = idx >> 6, ln = idx & 63; float sacc = 0.f;
#pragma unroll
        for (int w = 0; w < 8; ++w) sacc += red[(w * 9 + j) * 64 + ln];
        const int lo_ = perm ? ((ln & 32) + rope_perm32(ln & 31)) : ln;
        outc[(size_t)j * ldo + lo_] = sacc + (addb ? addb[ln] : 0.f); }
    __syncthreads();
}
__device__ __forceinline__ void prep_phase(const Params& P, LAS unsigned char* lds, int tid, int lane, int wave) {
    unsigned char* ws = P.ws;
    const float* mod = (const float*)(ws + OFF_MOD);
    LAS float* vec = (LAS float*)lds; LAS float* red = (LAS float*)(lds + 1024 * 12 * 4);
    for (int it = blockIdx.x; it < DEPTH * 100; it += gridDim.x) {
        const int l = it / 100, r = it % 100; const bool isin = r < 36; const int cb = isin ? r : r - 36;
        const float* sh = mod + (size_t)l * 9 * 6144 + (isin ? 0 : 3) * 1024;
        for (int i = tid; i < 9 * 1024; i += NTHR) { const int j = i >> 10, k = i & 1023; vec[k * 12 + j] = sh[(size_t)j * 6144 + k]; }
        __syncthreads();
        if (isin) gemv9_item(P.w_in + (size_t)l * DM * INW + cb * 64, INW, vec, red, (float*)(ws + OFF_BIN) + (size_t)l * 9 * INW + cb * 64, INW, nullptr, tid, lane, wave, cb * 64 < 1024);
        else gemv9_item(P.w1 + (size_t)l * DM * DFF + cb * 64, DFF, vec, red, (float*)(ws + OFF_B1) + (size_t)l * 9 * DFF + cb * 64, DFF, nullptr, tid, lane, wave);
    }
    const int gw = blockIdx.x * 8 + wave, NGW = gridDim.x * 8;
    bf16* H = (bf16*)(ws + OFF_H); float* ssq = (float*)(ws + OFF_SSQ);
    f32x4 gv[4];
#pragma unroll
    for (int j = 0; j < 4; ++j) gv[j] = *((const f32x4*)P.g_mix + lane + 64 * j);
    for (int row = gw; row < MT; row += NGW) {
        const float* xr = row < ML ? P.x + (size_t)row * DM : P.ctx + (size_t)(row - ML) * DM;
        const int bidx = row < ML ? (row >> 12) : 8;
        const float* sc = mod + (size_t)bidx * 6144 + 1024;
        f32x4 v[4]; float s = 0.f;
#pragma unroll
        for (int j = 0; j < 4; ++j) { v[j] = *((const f32x4*)xr + lane + 64 * j); s += (v[j][0] * v[j][0] + v[j][1] * v[j][1]) + (v[j][2] * v[j][2] + v[j][3] * v[j][3]); }
        const float tot = wave_sum(s);
        u32x2* o = (u32x2*)(H + (size_t)row * DM) + lane;
#pragma unroll
        for (int j = 0; j < 4; ++j) { const f32x4 scv = *((const f32x4*)sc + lane + 64 * j);
            const f32x4 y = v[j] * gv[j] * (scv + 1.f); u32x2 w; w.x = cvtpk(y[0], y[1]); w.y = cvtpk(y[2], y[3]); o[64 * j] = w; }
        if (lane < 16) ssq[(size_t)row * 16 + lane] = (lane == 0) ? tot : 0.f;
    }
}
__device__ __forceinline__ void final_norm_phase(const _Float16* xl, float* out, const float* g, int lane, int wave) {
    const int gw = blockIdx.x * 8 + wave, NGW = gridDim.x * 8;
    f32x4 gv[4];
#pragma unroll
    for (int j = 0; j < 4; ++j) gv[j] = *((const f32x4*)g + lane + 64 * j);
    for (int row = gw; row < ML; row += NGW) {
        const h16x4* xr = (const h16x4*)(xl + (size_t)row * DM) + lane; f32x4* orow = (f32x4*)(out + (size_t)row * DM) + lane;
        f32x4 v[4]; float s = 0.f;
#pragma unroll
        for (int j = 0; j < 4; ++j) { v[j] = __builtin_convertvector(xr[64 * j], f32x4); s += (v[j][0] * v[j][0] + v[j][1] * v[j][1]) + (v[j][2] * v[j][2] + v[j][3] * v[j][3]); }
        const float rstd = rsqrtf(wave_sum(s) * (1.f / DM) + EPS);
#pragma unroll
        for (int j = 0; j < 4; ++j) orow[64 * j] = v[j] * rstd * gv[j];
    }
}

constexpr int AT_KV = 0;
constexpr int AT_WS = 65536;
constexpr int AT_EX = 67584;
constexpr float THR = 8.f;

__device__ __forceinline__ void glds16(const void* gsrc, unsigned lds_dst) { unsigned keep;
    asm volatile("s_mov_b32 %0, m0\n\ts_mov_b32 m0, %2\n\ts_nop 0\n\tglobal_load_lds_dwordx4 %1, off\n\ts_mov_b32 m0, %0" : "=&s"(keep) : "v"(gsrc), "s"(lds_dst) : "memory"); }
__device__ __forceinline__ s16x4 vtr(const LAS unsigned char* p) { return __builtin_bit_cast(s16x4, __builtin_amdgcn_ds_read_tr16_b64_v4i16((LAS s16x4*)p)); }

__device__ __forceinline__ void attn_unit(const bf16* Z, bf16* MIX, int qrow0, int h, int ka, int nta, int kb, int ntb, float lam, float post, const float* gsub, LAS unsigned char* lds, int tid, int lane, int wave) {
    const int r32 = lane & 31, hi = lane >> 5, comp = wave >> 2, rg = wave & 3;
    const int NT = nta + ntb;
    const unsigned lds0 = (unsigned)(size_t)lds;
    unsigned ksrc[2], vsrc[2], kdst[2], vdst[2];
#pragma unroll
    for (int u = 0; u < 2; ++u) { const int bk = wave + 8 * u;
        { const int cmp = bk >> 3, j = bk & 7, kl = lane >> 3, c = (lane & 7) ^ kl; ksrc[u] = (unsigned)((8 * j + kl) * INW + 512 + h * 128 + cmp * 64 + c * 8); kdst[u] = (unsigned)(cmp * 8192 + j * 1024); }
        { const int db = bk >> 2, p = bk & 3, kl = lane >> 2, ch = lane & 3; vsrc[u] = (unsigned)((16 * p + kl) * INW + 1024 + h * 128 + db * 32 + ch * 8); vdst[u] = (unsigned)(32768 + db * 4096 + p * 1024); } }
#define AT_ROW(t) (((t) < nta) ? ka + 64 * (t) : kb + 64 * ((t) - nta))
#define AT_DMAK(t, buf) do { const bf16* rb_ = Z + (size_t)AT_ROW(t) * INW; _Pragma("unroll") for (int u = 0; u < 2; ++u) glds16(rb_ + ksrc[u], (unsigned)__builtin_amdgcn_readfirstlane(lds0 + (buf) * 16384 + kdst[u])); } while (0)
#define AT_DMAV(t, buf) do { const bf16* rb_ = Z + (size_t)AT_ROW(t) * INW; _Pragma("unroll") for (int u = 0; u < 2; ++u) glds16(rb_ + vsrc[u], (unsigned)__builtin_amdgcn_readfirstlane(lds0 + (buf) * 16384 + vdst[u])); } while (0)
#define AT_WAITBAR() do { asm volatile("s_waitcnt vmcnt(0)" ::: "memory"); __syncthreads(); } while (0)
    AT_DMAK(0, 0); AT_DMAK(1, 1); AT_DMAV(0, 0);
    bf16x8 qr[4];
    { const bf16* qp = Z + (size_t)(qrow0 + rg * 32 + r32) * INW + h * 128 + comp * 64 + hi * 8;
#pragma unroll
      for (int d0 = 0; d0 < 4; ++d0) qr[d0] = *(const bf16x8*)(qp + d0 * 16); }
    AT_WAITBAR();
    LAS float* wsf = (LAS float*)(lds + AT_WS) + wave * 64;
    f32x16 o[4];
#pragma unroll
    for (int d = 0; d < 4; ++d) o[d] = f32x16{};
    f32x16 negm = f32x16{};
    float mhat = 0.f, lsum = 0.f;
    const int koff = comp * 8192 + r32 * 128;
    const int voff = 32768 + ((lane >> 4) & 1) * 32 + (lane & 3) * 8 + (4 * hi + ((lane & 15) >> 2)) * 64;
    f32x16 C0, C1, P0, P1;
#define AT_ROWMAX(rm) do { float a_ = fmaxf(fmaxf(C0[0], C0[1]), C1[0]), b_ = fmaxf(fmaxf(C0[2], C0[3]), C1[1]); a_ = fmaxf(fmaxf(a_, C1[2]), C1[3]); \
        _Pragma("unroll") for (int r = 4; r < 16; r += 4) { a_ = fmaxf(fmaxf(a_, C0[r]), C0[r + 1]); b_ = fmaxf(fmaxf(b_, C0[r + 2]), C0[r + 3]); a_ = fmaxf(fmaxf(a_, C1[r]), C1[r + 1]); b_ = fmaxf(fmaxf(b_, C1[r + 2]), C1[r + 3]); } \
        rm = fmaxf(a_, b_); rm = fmaxf(rm, __shfl_xor(rm, 32)); } while (0)
    {
        const LAS unsigned char* kb_ = lds;
        C0 = negm; C1 = negm;
#pragma unroll
        for (int d0 = 0; d0 < 4; ++d0) { const int sw = (((2 * d0 + hi) ^ (r32 & 7)) << 4);
            C0 = __builtin_amdgcn_mfma_f32_32x32x16_bf16(*(const LAS bf16x8*)(kb_ + koff + sw), qr[d0], C0, 0, 0, 0);
            C1 = __builtin_amdgcn_mfma_f32_32x32x16_bf16(*(const LAS bf16x8*)(kb_ + koff + 32 * 128 + sw), qr[d0], C1, 0, 0, 0); }
        float rm; AT_ROWMAX(rm);
        mhat = rm;
#pragma unroll
        for (int r = 0; r < 16; ++r) { P0[r] = __builtin_amdgcn_exp2f(C0[r] - rm); P1[r] = __builtin_amdgcn_exp2f(C1[r] - rm); negm[r] = -mhat; }
    }
    __syncthreads();
    if (wave >= 4) __builtin_amdgcn_s_setprio(1);
    for (int t = 1; t < NT; ++t) {
        const LAS unsigned char* kb_ = lds + (t & 1) * 16384;
        const LAS unsigned char* vb_ = lds + ((t - 1) & 1) * 16384 + voff;
        if (t + 1 < NT) AT_DMAK(t + 1, (t + 1) & 1);
        AT_DMAV(t, t & 1);
        u32x4 pw[4]; float sacc = 0.f;
        C0 = negm; C1 = negm;
#pragma unroll
        for (int d0 = 0; d0 < 4; ++d0) { const int sw = (((2 * d0 + hi) ^ (r32 & 7)) << 4);
            C0 = __builtin_amdgcn_mfma_f32_32x32x16_bf16(*(const LAS bf16x8*)(kb_ + koff + sw), qr[d0], C0, 0, 0, 0);
            sacc += (P0[4 * d0] + P0[4 * d0 + 1]) + (P0[4 * d0 + 2] + P0[4 * d0 + 3]);
            pw[d0 >> 1][(d0 & 1) * 2] = cvtpk(P0[4 * d0], P0[4 * d0 + 1]); pw[d0 >> 1][(d0 & 1) * 2 + 1] = cvtpk(P0[4 * d0 + 2], P0[4 * d0 + 3]);
            C1 = __builtin_amdgcn_mfma_f32_32x32x16_bf16(*(const LAS bf16x8*)(kb_ + koff + 32 * 128 + sw), qr[d0], C1, 0, 0, 0);
            sacc += (P1[4 * d0] + P1[4 * d0 + 1]) + (P1[4 * d0 + 2] + P1[4 * d0 + 3]);
            pw[2 + (d0 >> 1)][(d0 & 1) * 2] = cvtpk(P1[4 * d0], P1[4 * d0 + 1]); pw[2 + (d0 >> 1)][(d0 & 1) * 2 + 1] = cvtpk(P1[4 * d0 + 2], P1[4 * d0 + 3]); }
        lsum += sacc;
        __builtin_amdgcn_sched_group_barrier(0x008, 2, 1);
#pragma unroll
        for (int i_ = 0; i_ < 6; ++i_) { __builtin_amdgcn_sched_group_barrier(0x400, 5, 1); __builtin_amdgcn_sched_group_barrier(0x008, 1, 1); }
        __builtin_amdgcn_sched_group_barrier(0x400, 2, 1);
        float rm; AT_ROWMAX(rm);
        bool resc = false;
        if (__any(rm > THR)) {
            const float dl = fmaxf(rm, 0.f);
            mhat += dl;
#pragma unroll
            for (int r = 0; r < 16; ++r) { C0[r] -= dl; C1[r] -= dl; negm[r] = -mhat; }
            const float f = __builtin_amdgcn_exp2f(-dl);
            lsum *= f;
            if (hi == 0) wsf[r32] = f;
            resc = true;
        }
#pragma unroll
        for (int d0 = 0; d0 < 4; ++d0)
#pragma unroll
            for (int ks = 0; ks < 4; ++ks) {
                const s16x4 lo = vtr(vb_ + d0 * 4096 + ks * 1024), hh = vtr(vb_ + d0 * 4096 + ks * 1024 + 512);
                const bf16x8 vf = (bf16x8){lo[0], lo[1], lo[2], lo[3], hh[0], hh[1], hh[2], hh[3]};
                o[d0] = __builtin_amdgcn_mfma_f32_32x32x16_bf16(__builtin_bit_cast(bf16x8, pw[ks]), vf, o[d0], 0, 0, 0);
                const int e = (d0 * 4 + ks);
                if (e < 8) { P0[2 * e] = __builtin_amdgcn_exp2f(C0[2 * e]); P0[2 * e + 1] = __builtin_amdgcn_exp2f(C0[2 * e + 1]); }
                else { P1[2 * e - 16] = __builtin_amdgcn_exp2f(C1[2 * e - 16]); P1[2 * e - 15] = __builtin_amdgcn_exp2f(C1[2 * e - 15]); }
            }
        if (resc) {
#pragma unroll
            for (int r = 0; r < 16; ++r) { const float fr_ = wsf[crow(r, hi)];
#pragma unroll
                for (int d = 0; d < 4; ++d) o[d][r] *= fr_; }
        }
        AT_WAITBAR();
    }
    __builtin_amdgcn_s_setprio(0);
    {
        const LAS unsigned char* vb_ = lds + ((NT - 1) & 1) * 16384 + voff;
        float sacc = 0.f;
#pragma unroll
        for (int r = 0; r < 16; ++r) sacc += P0[r] + P1[r];
        lsum += sacc;
        u32x4 pw[4];
        pw[0] = (u32x4){cvtpk(P0[0], P0[1]), cvtpk(P0[2], P0[3]), cvtpk(P0[4], P0[5]), cvtpk(P0[6], P0[7])};
        pw[1] = (u32x4){cvtpk(P0[8], P0[9]), cvtpk(P0[10], P0[11]), cvtpk(P0[12], P0[13]), cvtpk(P0[14], P0[15])};
        pw[2] = (u32x4){cvtpk(P1[0], P1[1]), cvtpk(P1[2], P1[3]), cvtpk(P1[4], P1[5]), cvtpk(P1[6], P1[7])};
        pw[3] = (u32x4){cvtpk(P1[8], P1[9]), cvtpk(P1[10], P1[11]), cvtpk(P1[12], P1[13]), cvtpk(P1[14], P1[15])};
#pragma unroll
        for (int d0 = 0; d0 < 4; ++d0)
#pragma unroll
            for (int ks = 0; ks < 4; ++ks) {
                const s16x4 lo = vtr(vb_ + d0 * 4096 + ks * 1024), hh = vtr(vb_ + d0 * 4096 + ks * 1024 + 512);
                const bf16x8 vf = (bf16x8){lo[0], lo[1], lo[2], lo[3], hh[0], hh[1], hh[2], hh[3]};
                o[d0] = __builtin_amdgcn_mfma_f32_32x32x16_bf16(__builtin_bit_cast(bf16x8, pw[ks]), vf, o[d0], 0, 0, 0);
            }
    }
#undef AT_ROW
#undef AT_DMAK
#undef AT_DMAV
#undef AT_WAITBAR
#undef AT_ROWMAX
    lsum += __shfl_xor(lsum, 32);
    const float inv = (comp == 0 ? 1.f : lam) / lsum;
    if (hi == 0) wsf[r32] = inv;
    asm volatile("s_waitcnt lgkmcnt(0)" ::: "memory");
    float rl[16];
#pragma unroll
    for (int r = 0; r < 16; ++r) rl[r] = wsf[crow(r, hi)];
    LAS float* ex = (LAS float*)(lds + AT_EX) + rg * 4096 + lane;
    if (comp == 1) {
#pragma unroll
        for (int d = 0; d < 4; ++d)
#pragma unroll
            for (int r = 0; r < 16; ++r) ex[(d * 16 + r) * 64] = o[d][r] * rl[r];
    }
    __syncthreads();
    if (comp == 0) {
        float ss[16];
#pragma unroll
        for (int r = 0; r < 16; ++r) { float s = 0.f;
#pragma unroll
            for (int d = 0; d < 4; ++d) { const float a = o[d][r] * rl[r] - ex[(d * 16 + r) * 64]; o[d][r] = a; s += a * a; }
            ss[r] = s; }
#pragma unroll
        for (int r = 0; r < 16; ++r) {
#pragma unroll
            for (int off = 1; off < 32; off <<= 1) ss[r] += __shfl_xor(ss[r], off);
            ss[r] = rsqrtf(ss[r] * (1.f / 128.f) + EPS) * post; }
        LAS bf16* stg = (LAS bf16*)((LAS float*)(lds + AT_EX) + rg * 4096);
#pragma unroll
        for (int d = 0; d < 4; ++d) { const float gs = gsub[d * 32 + r32];
#pragma unroll
            for (int r = 0; r < 16; ++r) stg[crow(r, hi) * 136 + d * 32 + r32] = f2bf(o[d][r] * ss[r] * gs); }
#pragma unroll
        for (int i = 0; i < 8; ++i) { const int idx = lane + 64 * i, row = idx >> 4, ch = idx & 15;
            const u32x4 v = *(const LAS u32x4*)(stg + row * 136 + ch * 8);
            *(u32x4*)(MIX + (size_t)(qrow0 + rg * 32 + row) * DM + h * 128 + ch * 8) = v; }
    }
    __syncthreads();
}

__device__ __forceinline__ void gate_item(const bf16* Z, bf16* MIX, int tok0, int g, const bf16* Wsp_lg, const float* bsp_lg, const float* gv_l, LAS unsigned char* lds, int tid, int lane, int wave) {
    LAS bf16* vnT = (LAS bf16*)lds;
    {
        const int q = tid >> 2, cq = tid & 3;
        const bf16* src = Z + (size_t)(tok0 + q) * INW + 1792 + g * 64 + cq * 16;
        const u32x4 a = *(const u32x4*)src, b = *(const u32x4*)(src + 8);
        float x[16];
#pragma unroll
        for (int i = 0; i < 4; ++i) { x[2 * i] = bflo(a[i]); x[2 * i + 1] = bfhi(a[i]); x[8 + 2 * i] = bflo(b[i]); x[8 + 2 * i + 1] = bfhi(b[i]); }
        float ss = 0.f;
#pragma unroll
        for (int i = 0; i < 16; ++i) ss += x[i] * x[i];
        ss += __shfl_xor(ss, 1); ss += __shfl_xor(ss, 2);
        const float rstd = rsqrtf(ss * (1.f / 64.f) + EPS);
#pragma unroll
        for (int i = 0; i < 16; ++i) vnT[(cq * 16 + i) * 136 + q] = f2bf(x[i] * rstd * gv_l[g * 64 + cq * 16 + i]);
    }
    __syncthreads();
    const int r32 = lane & 31, hi = lane >> 5, pb = wave & 3, cb = wave >> 2;
    f32x16 acc = f32x16{};
#pragma unroll
    for (int s = 0; s < 8; ++s) {
        const bf16x8 A = *(const bf16x8*)(Wsp_lg + (size_t)(pb * 32 + r32) * 128 + 16 * s + 8 * hi);
        const bf16x8 B = *(const LAS bf16x8*)(vnT + (cb * 32 + r32) * 136 + 16 * s + 8 * hi);
        acc = __builtin_amdgcn_mfma_f32_32x32x16_bf16(A, B, acc, 0, 0, 0);
    }
    const int c = cb * 32 + r32;
#pragma unroll
    for (int r = 0; r < 16; ++r) { const int p = pb * 32 + crow(r, hi); const size_t tok = (size_t)(tok0 + p);
        const float u = bf2f(Z[tok * INW + 1536 + g * 64 + c]);
        MIX[tok * DM + 512 + g * 64 + c] = f2bf((acc[r] + bsp_lg[p]) * u); }
    __syncthreads();
}

__device__ __forceinline__ void pool_item(const bf16* Z, bf16* MIX, int tok0, int g, const bf16* WpT_lg, const float* sp_l, LAS unsigned char* lds, int tid, int lane, int wave) {
    LAS bf16* pt = (LAS bf16*)lds;
    LAS bf16* dT = (LAS bf16*)(lds + 144 * 72 * 2);
    const int TS = tok0 < ML ? SEQ : CTXL, pos0 = tok0 & (TS - 1);
    for (int idx = tid; idx < 144 * 8; idx += NTHR) { const int row = idx >> 3, ch = idx & 7, pos = pos0 - 8 + row;
        u32x4 v = {0u, 0u, 0u, 0u};
        if (pos >= 0 && pos < TS) v = *(const u32x4*)(Z + (size_t)(tok0 - 8 + row) * INW + 2048 + g * 64 + ch * 8);
        *(LAS u32x4*)(pt + row * 72 + ch * 8) = v; }
    __syncthreads();
    {
        const int t = tid >> 2, cq = tid & 3, w = 2 << g, half = w >> 1, pos = pos0 + t;
        const int lo = max(pos - half, 0), hi_ = min(pos + half, TS);
        const float rc = 1.f / (float)(hi_ - lo);
        float sum[16];
#pragma unroll
        for (int i = 0; i < 16; ++i) sum[i] = 0.f;
        for (int k = 0; k < w; ++k) { const LAS bf16* rp = pt + (t + 8 - half + k) * 72 + cq * 16;
            const u32x4 a = *(const LAS u32x4*)rp, b = *(const LAS u32x4*)(rp + 8);
#pragma unroll
            for (int i = 0; i < 4; ++i) { sum[2 * i] += bflo(a[i]); sum[2 * i + 1] += bfhi(a[i]); sum[8 + 2 * i] += bflo(b[i]); sum[8 + 2 * i + 1] += bfhi(b[i]); } }
        const LAS bf16* xp = pt + (t + 8) * 72 + cq * 16;
        const u32x4 a = *(const LAS u32x4*)xp, b = *(const LAS u32x4*)(xp + 8);
        float x[16];
#pragma unroll
        for (int i = 0; i < 4; ++i) { x[2 * i] = bflo(a[i]); x[2 * i + 1] = bfhi(a[i]); x[8 + 2 * i] = bflo(b[i]); x[8 + 2 * i + 1] = bfhi(b[i]); }
        u32x4 o0, o1;
#pragma unroll
        for (int i = 0; i < 4; ++i) { o0[i] = cvtpk(sum[2 * i] * rc - x[2 * i], sum[2 * i + 1] * rc - x[2 * i + 1]); o1[i] = cvtpk(sum[8 + 2 * i] * rc - x[8 + 2 * i], sum[8 + 2 * i + 1] * rc - x[8 + 2 * i + 1]); }
        *(LAS u32x4*)(dT + t * 72 + cq * 16) = o0; *(LAS u32x4*)(dT + t * 72 + cq * 16 + 8) = o1;
    }
    __syncthreads();
    const int r32 = lane & 31, hi = lane >> 5, tb = wave & 3, eb = wave >> 2;
    f32x16 acc = f32x16{};
#pragma unroll
    for (int s = 0; s < 4; ++s) {
        const bf16x8 A = *(const LAS bf16x8*)(dT + (tb * 32 + r32) * 72 + 16 * s + 8 * hi);
        const bf16x8 B = *(const bf16x8*)(WpT_lg + (size_t)(eb * 32 + r32) * 64 + 16 * s + 8 * hi);
        acc = __builtin_amdgcn_mfma_f32_32x32x16_bf16(A, B, acc, 0, 0, 0);
    }
    const int e = eb * 32 + r32; const float sp = sp_l[g * 64 + e];
#pragma unroll
    for (int r = 0; r < 16; ++r) { const size_t tok = (size_t)(tok0 + tb * 32 + crow(r, hi)); MIX[tok * DM + 768 + g * 64 + e] = f2bf(acc[r] * sp); }
    __syncthreads();
}

__device__ __forceinline__ void small_item(const bf16* Z, bf16* MIX, int tok0, int g, const bf16* Wsp_lg, const float* bsp_lg, const float* gv_l, const bf16* WpT_lg, const float* sp_l, LAS unsigned char* lds, int tid, int lane, int wave) {
    LAS bf16* vnT = (LAS bf16*)lds;
    LAS bf16* pt = (LAS bf16*)(lds + 17408);
    LAS bf16* dT = (LAS bf16*)(lds + 38144);
    LAS bf16* uT = (LAS bf16*)(lds + 56576);
    LAS bf16* og = (LAS bf16*)(lds + 75008);
    LAS bf16* op = (LAS bf16*)(lds + 93440);
    const int TS = tok0 < ML ? SEQ : CTXL, pos0 = tok0 & (TS - 1);
    const int r32 = lane & 31, hi = lane >> 5, rb = wave & 3, cb = wave >> 2;
    const int q = tid >> 2, cq = tid & 3;
    const bf16* zrow = Z + (size_t)(tok0 + q) * INW + g * 64 + cq * 16;
    const u32x4 ga = *(const u32x4*)(zrow + 1792), gb = *(const u32x4*)(zrow + 1792 + 8);
    const u32x4 ua = *(const u32x4*)(zrow + 1536), ub = *(const u32x4*)(zrow + 1536 + 8);
    u32x4 pv[3]; int prow[3];
#pragma unroll
    for (int i = 0; i < 3; ++i) { const int idx = tid + NTHR * i; prow[i] = idx >> 3; const int ch = idx & 7, pos = pos0 - 8 + prow[i];
        pv[i] = (u32x4){0u, 0u, 0u, 0u};
        if (idx < 144 * 8 && pos >= 0 && pos < TS) pv[i] = *(const u32x4*)(Z + (size_t)(tok0 - 8 + prow[i]) * INW + 2048 + g * 64 + ch * 8); }
    bf16x8 Ag[8];
#pragma unroll
    for (int s_ = 0; s_ < 8; ++s_) Ag[s_] = *(const bf16x8*)(Wsp_lg + (size_t)(rb * 32 + r32) * 128 + 16 * s_ + 8 * hi);
    {
        float x[16];
#pragma unroll
        for (int i = 0; i < 4; ++i) { x[2 * i] = bflo(ga[i]); x[2 * i + 1] = bfhi(ga[i]); x[8 + 2 * i] = bflo(gb[i]); x[8 + 2 * i + 1] = bfhi(gb[i]); }
        float ss = 0.f;
#pragma unroll
        for (int i = 0; i < 16; ++i) ss += x[i] * x[i];
        ss += __shfl_xor(ss, 1); ss += __shfl_xor(ss, 2);
        const float rstd = rsqrtf(ss * (1.f / 64.f) + EPS);
#pragma unroll
        for (int i = 0; i < 16; ++i) vnT[(cq * 16 + i) * 136 + q] = f2bf(x[i] * rstd * gv_l[g * 64 + cq * 16 + i]);
        *(LAS u32x4*)(uT + q * 72 + cq * 16) = ua; *(LAS u32x4*)(uT + q * 72 + cq * 16 + 8) = ub;
#pragma unroll
        for (int i = 0; i < 3; ++i) { const int idx = tid + NTHR * i; if (idx < 144 * 8) *(LAS u32x4*)(pt + prow[i] * 72 + (idx & 7) * 8) = pv[i]; }
    }
    __syncthreads();
    {
        const int t = q, w = 2 << g, half = w >> 1, pos = pos0 + t;
        const int lo = max(pos - half, 0), hi_ = min(pos + half, TS);
        const float rc = 1.f / (float)(hi_ - lo);
        float sum[16];
#pragma unroll
        for (int i = 0; i < 16; ++i) sum[i] = 0.f;
        for (int k = 0; k < w; ++k) { const LAS bf16* rp = pt + (t + 8 - half + k) * 72 + cq * 16;
            const u32x4 a = *(const LAS u32x4*)rp, b = *(const LAS u32x4*)(rp + 8);
#pragma unroll
            for (int i = 0; i < 4; ++i) { sum[2 * i] += bflo(a[i]); sum[2 * i + 1] += bfhi(a[i]); sum[8 + 2 * i] += bflo(b[i]); sum[8 + 2 * i + 1] += bfhi(b[i]); } }
        const LAS bf16* xp = pt + (t + 8) * 72 + cq * 16;
        const u32x4 a = *(const LAS u32x4*)xp, b = *(const LAS u32x4*)(xp + 8);
        float x[16];
#pragma unroll
        for (int i = 0; i < 4; ++i) { x[2 * i] = bflo(a[i]); x[2 * i + 1] = bfhi(a[i]); x[8 + 2 * i] = bflo(b[i]); x[8 + 2 * i + 1] = bfhi(b[i]); }
        u32x4 o0, o1;
#pragma unroll
        for (int i = 0; i < 4; ++i) { o0[i] = cvtpk(sum[2 * i] * rc - x[2 * i], sum[2 * i + 1] * rc - x[2 * i + 1]); o1[i] = cvtpk(sum[8 + 2 * i] * rc - x[8 + 2 * i], sum[8 + 2 * i + 1] * rc - x[8 + 2 * i + 1]); }
        *(LAS u32x4*)(dT + t * 72 + cq * 16) = o0; *(LAS u32x4*)(dT + t * 72 + cq * 16 + 8) = o1;
    }
    {
        f32x16 acc = f32x16{};
#pragma unroll
        for (int s_ = 0; s_ < 8; ++s_) { const bf16x8 B = *(const LAS bf16x8*)(vnT + (cb * 32 + r32) * 136 + 16 * s_ + 8 * hi); acc = __builtin_amdgcn_mfma_f32_32x32x16_bf16(Ag[s_], B, acc, 0, 0, 0); }
        const int c = cb * 32 + r32;
#pragma unroll
        for (int r = 0; r < 16; ++r) { const int p = rb * 32 + crow(r, hi);
            og[p * 72 + c] = f2bf((acc[r] + bsp_lg[p]) * bf2f(uT[p * 72 + c])); }
    }
    __syncthreads();
    {
        f32x16 acc = f32x16{};
#pragma unroll
        for (int s_ = 0; s_ < 4; ++s_) {
            const bf16x8 A = *(const LAS bf16x8*)(dT + (rb * 32 + r32) * 72 + 16 * s_ + 8 * hi);
            const bf16x8 B = *(const bf16x8*)(WpT_lg + (size_t)(cb * 32 + r32) * 64 + 16 * s_ + 8 * hi);
            acc = __builtin_amdgcn_mfma_f32_32x32x16_bf16(A, B, acc, 0, 0, 0); }
        const int e = cb * 32 + r32; const float sp = sp_l[g * 64 + e];
#pragma unroll
        for (int r = 0; r < 16; ++r) op[(rb * 32 + crow(r, hi)) * 72 + e] = f2bf(acc[r] * sp);
    }
    __syncthreads();
    {
        bf16* mrow = MIX + (size_t)(tok0 + q) * DM + g * 64 + cq * 16;
        *(u32x4*)(mrow + 512) = *(const LAS u32x4*)(og + q * 72 + cq * 16); *(u32x4*)(mrow + 512 + 8) = *(const LAS u32x4*)(og + q * 72 + cq * 16 + 8);
        *(u32x4*)(mrow + 768) = *(const LAS u32x4*)(op + q * 72 + cq * 16); *(u32x4*)(mrow + 768 + 8) = *(const LAS u32x4*)(op + q * 72 + cq * 16 + 8);
    }
}

#define XB_TMO      128
#define XB_XCNT(j)  (256  + 64 * (j))
#define XB_XSUB(j)  (1280 + 64 * (j))
#define XB_XGEN(j)  (2304 + 64 * (j))
#define XB_TOP      3328
#define XB_TOPGEN   3392
#define XCD_BAR_WORDS 3456
#define XB_SPIN_CAP (1u << 18)

__device__ __forceinline__ unsigned xb_ld(unsigned* p)              { return __hip_atomic_load(p, __ATOMIC_RELAXED, __HIP_MEMORY_SCOPE_AGENT); }
__device__ __forceinline__ unsigned xb_add(unsigned* p, unsigned v) { return __hip_atomic_fetch_add(p, v, __ATOMIC_RELAXED, __HIP_MEMORY_SCOPE_AGENT); }
__device__ __forceinline__ unsigned xb_xcc_id() { return (unsigned)__builtin_amdgcn_s_getreg((3 << 11) | 20) & 0xFu; }
#define XB_SPIN(cond, bar) do { unsigned _sp = 0; while (cond) { __builtin_amdgcn_s_sleep(1); \
    if ((++_sp & 255u) == 0u) { if (xb_ld(&(bar)[XB_TMO])) break; if (_sp > XB_SPIN_CAP) { atomicAdd(&(bar)[XB_TMO], 1u); break; } } } } while (0)

struct XcdBarrier {
    unsigned* bar; unsigned x;
    volatile LAS unsigned* st;
};

__device__ __forceinline__ XcdBarrier xcd_barrier_post(unsigned* bar, volatile LAS unsigned* st) {
    XcdBarrier b; b.bar = bar; b.x = xb_xcc_id(); b.st = st;
    if (threadIdx.x == 0) (void)xb_add(&bar[XB_XCNT(b.x)], 1u);
    return b;
}
__device__ __forceinline__ void xcd_barrier_complete(unsigned* bar, unsigned x, unsigned& nloc, unsigned& nx) {
    const unsigned G = gridDim.x * gridDim.y * gridDim.z;
    unsigned sum, cnt, mine, sp = 0u;
    for (;;) {
        sum = 0u; cnt = 0u; mine = 0u;
#pragma unroll
        for (unsigned j = 0; j < 16; ++j) { const unsigned c = xb_ld(&bar[XB_XCNT(j)]); sum += c; cnt += (c > 0u) ? 1u : 0u; mine = (j == x) ? c : mine; }
        if (sum == G) break;
        __builtin_amdgcn_s_sleep(1);
        if ((++sp & 255u) == 0u) { if (xb_ld(&bar[XB_TMO])) break; if (sp > XB_SPIN_CAP) { atomicAdd(&bar[XB_TMO], 1u); break; } }
    }
    nloc = mine > 0u ? mine : 1u; nx = cnt > 0u ? cnt : 1u;
}

__device__ __forceinline__ void xcd_barrier(const XcdBarrier& b) {
    asm volatile("s_waitcnt vmcnt(0)" ::: "memory");
    __syncthreads();
    if (threadIdx.x == 0) {
        unsigned* bar = b.bar;
        __builtin_amdgcn_s_waitcnt(0);
        unsigned nloc = b.st[0], nx = b.st[1];
        if (nloc == 0u) { xcd_barrier_complete(bar, b.x, nloc, nx); b.st[0] = nloc; b.st[1] = nx; }
        const unsigned old = xb_add(&bar[XB_XSUB(b.x)], 1u);
        const unsigned gen = old / nloc;
        if (old + 1u == (gen + 1u) * nloc) {
            __builtin_amdgcn_fence(__ATOMIC_RELEASE, "agent");
            asm volatile("s_waitcnt vmcnt(0)" ::: "memory");
            const unsigned og = xb_add(&bar[XB_TOP], 1u);
            const unsigned tg = og / nx;
            if (og + 1u == (tg + 1u) * nx) xb_add(&bar[XB_TOPGEN], 1u);
            else XB_SPIN(xb_ld(&bar[XB_TOPGEN]) == tg, bar);
            __builtin_amdgcn_fence(__ATOMIC_ACQUIRE, "agent");
            xb_add(&bar[XB_XGEN(b.x)], 1u);
            asm volatile("s_waitcnt vmcnt(0)" ::: "memory");
        } else {
            XB_SPIN(xb_ld(&bar[XB_XGEN(b.x)]) == gen, bar);
            __builtin_amdgcn_fence(__ATOMIC_ACQUIRE, "agent");
            asm volatile("s_waitcnt vmcnt(0)" ::: "memory");
        }
    }
    __syncthreads();
}

__global__ void __launch_bounds__(NTHR, 2) fwd_megakernel(Params P) {
    extern __shared__ __attribute__((aligned(16))) unsigned char lds_raw[];
    LAS unsigned char* lds = (LAS unsigned char*)lds_raw;
    cg::grid_group grid = cg::this_grid();
    const int G = gridDim.x, bid = blockIdx.x;
#define TLW const int tid = opaque_tid(), lane = tid & 63, wave = __builtin_amdgcn_readfirstlane(tid >> 6); (void)tid; (void)lane; (void)wave
    unsigned char* ws = P.ws;
    float* mod = (float*)(ws + OFF_MOD);
    const float* cosT = (const float*)(ws + OFF_TAB); const float* sinT = cosT + 1024; const float* lamv = cosT + 2048;
    bf16* H = (bf16*)(ws + OFF_H); bf16* Z = (bf16*)(ws + OFF_Z); bf16* MIX = (bf16*)(ws + OFF_MIX); bf16* HID = (bf16*)(ws + OFF_HID);
    _Float16* XC = (_Float16*)(ws + OFF_XC); _Float16* XL = (_Float16*)(ws + OFF_XL);

    {   TLW;
        if (bid == 0) for (int i = tid; i < XCD_BAR_WORDS; i += NTHR) ((unsigned*)(ws + OFF_BAR))[i] = 0u;
        if (tid < 16) ((LAS unsigned*)(lds + LDS_BYTES - 64))[tid] = 0u;
        __syncthreads();
    }
#ifndef NO_PRO
    { TLW; prologue(P, lds, tid, lane, wave); }
#endif
    grid.sync();
    const XcdBarrier xbar = xcd_barrier_post((unsigned*)(ws + OFF_BAR), (volatile LAS unsigned*)(lds + LDS_BYTES - 64));
#define GRID_BAR() xcd_barrier(xbar)
    float* SSQ = (float*)(ws + OFF_SSQ);
    { TLW; prep_phase(P, lds, tid, lane, wave); }
    GRID_BAR();

    for (int l = 0; l < DEPTH; ++l) {
        const bool last = (l == DEPTH - 1);
        const void* xl_src = (l == 0) ? (const void*)P.x : (const void*)XL;
        const void* xc_src = (l == 0) ? (const void*)P.ctx : (const void*)XC;
        const float* mod_l = mod + (size_t)l * 9 * 6144;
        {
            pg8::Gemm g{H, (const bf16*)(ws + OFF_WIN) + (size_t)l * INW * DM, MT, INW, DM, DM}; pg8::StaticOrder S; S.init(MT, INW, G, bid);
            EpiInProj E{Z, cosT, sinT, SSQ, (const float*)(ws + OFF_BIN) + (size_t)l * 9 * INW};
#ifndef NO_G1
            pg8::gemm_phase<EpiInProj, pg8::StaticOrder, true, true>(lds, g, S, E);
#endif
        }
        GRID_BAR();
        {
            TLW;
            const float lam = lamv[l];
            const float lam_init = 0.8f - 0.6f * expf(-0.3f * (float)l);
            const float post = 1.f - lam_init;
            const float* gsub = P.g_sub + l * 128;
            const int n_lat = NB * 4 * (SEQ / 128);
            const int n_ctx = last ? 0 : NB * 4 * (CTXL / 128);
#ifndef NO_ATTN
            const int vcu = (G % 8 == 0) ? (bid % 8) * (G / 8) + bid / 8 : bid;
            for (int u = vcu; u < n_lat + n_ctx; u += G) {
                if (u < n_lat) { const int b = u >> 7, h = (u >> 5) & 3, qb = u & 31;
                    attn_unit(Z, MIX, b * SEQ + qb * 128, h, ML + b * CTXL, CTXL / 64, b * SEQ, SEQ / 64, lam, post, gsub, lds, tid, lane, wave);
                } else { const int v = u - n_lat, b = v >> 3, h = (v >> 1) & 3, qb = v & 1;
                    attn_unit(Z, MIX, ML + b * CTXL + qb * 128, h, ML + b * CTXL, CTXL / 64, 0, 0, lam, post, gsub, lds, tid, lane, wave); }
            }
#endif
#ifndef NO_SMALL
            const int nblk = (last ? ML : MT) / 128;
            for (int it = bid; it < nblk * 4; it += G) {
                const int tb = it >> 2, g = it & 3;
                small_item(Z, MIX, tb * 128, g, (const bf16*)(ws + OFF_WSP) + (size_t)(l * 4 + g) * 16384, P.b_sp + (l * 4 + g) * 128, P.g_v + l * 256,
                           (const bf16*)(ws + OFF_WPT) + (size_t)(l * 4 + g) * 4096, P.s_pool + l * 256, lds, tid, lane, wave);
            }
#endif
        }
        GRID_BAR();
        const int Mrows = last ? ML : MT;
        {
            pg8::Gemm g{MIX, (const bf16*)(ws + OFF_WOUT) + (size_t)l * DM * DM, Mrows, DM, DM, DM}; pg8::StaticOrder S; S.init(Mrows, DM, G, bid);
            EpiRes E{xl_src, XL, xc_src, XC, (l == 0) ? 1 : 0, mod_l + 2 * 1024, P.g_mlp + l * DM, mod_l + 4 * 1024, H, SSQ};
#ifndef NO_G2
            pg8::gemm_phase<EpiRes, pg8::StaticOrder, true, true>(lds, g, S, E);
#endif
        }
        GRID_BAR();
        {
            pg8::Gemm g{H, (const bf16*)(ws + OFF_W1) + (size_t)l * DFF * DM, Mrows, DFF, DM, DM}; pg8::StaticOrder S; S.init(Mrows, DFF, G, bid);
            EpiSqRelu E{HID, DFF, SSQ, (const float*)(ws + OFF_B1) + (size_t)l * 9 * DFF};
#ifndef NO_G3
            pg8::gemm_phase<EpiSqRelu, pg8::StaticOrder, true, true>(lds, g, S, E);
#endif
        }
        GRID_BAR();
        {
            pg8::Gemm g{HID, (const bf16*)(ws + OFF_W2) + (size_t)l * DM * DFF, ML, DM, DFF, DFF}; pg8::StaticOrder S; S.init(ML, DM, G, bid);
            EpiRes E{XL, XL, XC, XC, 0, mod_l + 5 * 1024, last ? (const float*)nullptr : P.g_mix + (l + 1) * DM, mod_l + 9 * 6144 + 1 * 1024, H, SSQ};
#ifndef NO_G4
            pg8::gemm_phase<EpiRes, pg8::StaticOrder, true, true>(lds, g, S, E);
#endif
        }
        if (!last) {
            for (int su = bid; su < 256; su += G) {
                const int tile = su >> 3, ks = su & 7;
                pg8::Gemm g{HID + (size_t)ML * DFF + ks * 512, (const bf16*)(ws + OFF_W2) + (size_t)l * DM * DFF + ks * 512, MC, DM, 512, DFF};
                OneUnit S{{tile >> 2, tile & 3}};
                EpiPartial E{P.out + (size_t)ks * MC * DM};
                pg8::gemm_phase<EpiPartial, OneUnit, false, true>(lds, g, S, E);
            }
            GRID_BAR();
            { TLW; ctx_finalize_phase(XC, (const float*)P.out, mod_l + 8 * 6144 + 5 * 1024, P.g_mix + (l + 1) * DM, mod_l + 9 * 6144 + 8 * 6144 + 1 * 1024, H, SSQ, lane, wave); }
        }
        GRID_BAR();
    }
    { TLW; final_norm_phase(XL, P.out, P.g_final, lane, wave); }
}

extern "C" void kernel_launch(void* const* d_in, const int* in_sizes, int n_in, void* d_out, int out_size, void* d_ws, size_t ws_size, hipStream_t stream) {
    static int grid_blocks = 0;
    if (grid_blocks == 0) {
        if (n_in != 23 || ws_size < WS_NEED) { fprintf(stderr, "kernel_launch: unexpected n_in %d or ws_size %zu (need %zu)\n", n_in, ws_size, (size_t)WS_NEED); grid_blocks = -1; return; }
        int dev = 0, cus = 0, per_cu = 0;
        hipGetDevice(&dev);
        hipDeviceGetAttribute(&cus, hipDeviceAttributeMultiprocessorCount, dev);
        if (hipFuncSetAttribute((const void*)fwd_megakernel, hipFuncAttributeMaxDynamicSharedMemorySize, LDS_BYTES) != hipSuccess) { fprintf(stderr, "kernel_launch: hipFuncSetAttribute failed\n"); grid_blocks = -1; return; }
        hipOccupancyMaxActiveBlocksPerMultiprocessor(&per_cu, (const void*)fwd_megakernel, NTHR, LDS_BYTES);
        if (per_cu < 1) { fprintf(stderr, "kernel_launch: occupancy query says %d blocks per CU\n", per_cu); per_cu = 1; }
        (void)hipGetLastError();
        grid_blocks = cus * per_cu;
    }
    if (grid_blocks < 0) return;
    Params p{};
    const float** pp = (const float**)&p;
    for (int i = 0; i < 23; ++i) pp[i] = (const float*)d_in[i];
    p.out = (float*)d_out; p.ws = (unsigned char*)d_ws;
    void* args[] = {&p};
    hipError_t e = hipLaunchCooperativeKernel((const void*)fwd_megakernel, dim3(grid_blocks), dim3(NTHR), args, LDS_BYTES, stream);
    if (e != hipSuccess) fprintf(stderr, "cooperative launch failed: %s (grid %d)\n", hipGetErrorString(e), grid_blocks);
}
```

```cpp
#include <hip/hip_runtime.h>
#include <hip/hip_cooperative_groups.h>
#include <cstdio>
#include <cstdint>
namespace cg = cooperative_groups;
__device__ __forceinline__ int opaque_tid() { int t = threadIdx.x; asm volatile("" : "+v"(t)); return t; }
namespace pg8 {
#define PG8_LAS __attribute__((address_space(3)))
typedef unsigned short bf16_t;
typedef short bf16x8 __attribute__((ext_vector_type(8)));
typedef float f32x4 __attribute__((ext_vector_type(4)));
typedef unsigned u32x4 __attribute__((ext_vector_type(4)));
constexpr int BM = 256, BK = 64, HALF = 128, HTB = HALF * BK * 2  , STAGE_BYTES = 8 * HTB, NXCD = 8, WGM = 8;

__host__ __device__ __forceinline__ int lds_byte(int r, int c) { const int st = (r >> 4) * 2 + (c >> 5), rr = r & 15, cc = c & 31, ob = rr * 64 + cc * 2; return st * 1024 + (ob ^ (((ob >> 9) & 1) << 5)); }
__host__ __device__ __forceinline__ void stage_rc(int b, int& R, int& C) { const int st = b / 1024, sb = b % 1024, swz = sb ^ (((sb >> 9) & 1) << 5); R = (st >> 1) * 16 + swz / 64; C = (st & 1) * 32 + (swz % 64) / 2; }
__host__ __device__ __forceinline__ int perm32(int rho) { const int n = rho >> 4, i = rho & 15; return 8 * (i >> 2) + 4 * n + (i & 3); }

struct Unit { int pm, pn; };
struct Gemm { const bf16_t* A; const bf16_t* Bt; int M, N, K, ld; };

struct StaticOrder {
    int nM, nN, nwg, G, c;
    __host__ __device__ void init(int M, int N, int G_, int c_) { nM = M / BM; nN = N / BM; nwg = nM * nN; G = G_; c = c_; }
    __host__ __device__ bool next(int i, Unit& u) const {
        const long L = (long)i * G + c; if (L >= nwg) return false;
        int wgid = (int)L; { const int q = nwg / NXCD, r = nwg % NXCD, xcd = wgid % NXCD, off = wgid / NXCD; wgid = (xcd < r ? xcd * (q + 1) : r * (q + 1) + (xcd - r) * q) + off; }
        const int nig = WGM * nN, gid = wgid / nig, fm = gid * WGM, gsz = (nM - fm) < WGM ? (nM - fm) : WGM;
        u.pm = fm + ((wgid % nig) % gsz); u.pn = (wgid % nig) / gsz; return true;
    }
    __device__ __forceinline__ void a_ready(const Unit&) const {}
    __device__ __forceinline__ void done(const Unit&) const {}
};

__device__ __forceinline__ unsigned cvt_pk_bf16(float lo, float hi) { unsigned r; asm volatile("v_cvt_pk_bf16_f32 %0, %1, %2" : "=v"(r) : "v"(lo), "v"(hi)); return r; }
typedef float f32x2 __attribute__((ext_vector_type(2)));
__device__ __forceinline__ f32x2 gelu_pk(f32x2 v) {
    const f32x2 av = __builtin_elementwise_abs(v), d = av * 0.2316418882f + 1.0f;
    f32x2 t; t.x = __builtin_amdgcn_rcpf(d.x); t.y = __builtin_amdgcn_rcpf(d.y);
    f32x2 q = t * 0.5307027145f + (-0.7265760135f); q = q * t + 0.7107068705f; q = q * t + (-0.142248368f); q = q * t + 0.127414796f; q = q * t;
    const f32x2 s = (v * v) * (-0.72134752044f);
    f32x2 e; e.x = __builtin_amdgcn_exp2f(s.x); e.y = __builtin_amdgcn_exp2f(s.y);
    const f32x2 m = v * (q * e), r = v - m;
    f32x2 o; o.x = v.x < 0.f ? m.x : r.x; o.y = v.y < 0.f ? m.y : r.y; return o;
}

template <int ACT  > struct EpiBf16 {
    static constexpr bool PERM = true, AFTER_DRAIN = false; static_assert(ACT == 0 || ACT == 1, "EpiBf16: ACT is 0 (none) or 1 (gelu_pk)");
    bf16_t* O; int ldc; const float* bias; int split_cols; size_t split_stride; float scale0;
    __device__ __forceinline__ void operator()(const f32x4 (&acc)[2][2][4][2], const Unit& u, int wr, int wc, int fr, int fq) const {
        const int row0 = u.pm * BM + wr * 64 + fr; int colt = u.pn * BM; bf16_t* base = O;
        float sc = 1.f; if (split_cols) { const int t = colt / split_cols; base += (size_t)t * split_stride; colt -= t * split_cols; if (t == 0) sc = scale0; }
        const int col0 = colt + wc * 32 + 8 * fq, bcol0 = u.pn * BM + wc * 32 + 8 * fq;
        f32x4 bv[2][2];
#pragma unroll
        for (int bj = 0; bj < 2; ++bj)
#pragma unroll
            for (int n = 0; n < 2; ++n) bv[bj][n] = bias ? *(const f32x4*)(bias + bcol0 + bj * HALF + 4 * n) : (f32x4){0.f, 0.f, 0.f, 0.f};
#pragma unroll
        for (int ai = 0; ai < 2; ++ai)
#pragma unroll
            for (int m = 0; m < 4; ++m) { bf16_t* rowp = base + (size_t)(row0 + ai * HALF + m * 16) * ldc + col0;
#pragma unroll
                for (int bj = 0; bj < 2; ++bj) { f32x4 v0 = acc[ai][bj][m][0] + bv[bj][0], v1 = acc[ai][bj][m][1] + bv[bj][1];
                    if (ACT == 1) { f32x2 a = gelu_pk((f32x2){v0[0], v0[1]}), b = gelu_pk((f32x2){v0[2], v0[3]}), c = gelu_pk((f32x2){v1[0], v1[1]}), d = gelu_pk((f32x2){v1[2], v1[3]});
                        v0 = (f32x4){a.x, a.y, b.x, b.y}; v1 = (f32x4){c.x, c.y, d.x, d.y}; }
                    v0 = v0 * sc; v1 = v1 * sc; u32x4 w; w.x = cvt_pk_bf16(v0[0], v0[1]); w.y = cvt_pk_bf16(v0[2], v0[3]); w.z = cvt_pk_bf16(v1[0], v1[1]); w.w = cvt_pk_bf16(v1[2], v1[3]);
                    *(u32x4*)(rowp + bj * HALF) = w; } }
    }
};
template <class Epi, class Sched, bool ALIGN_EPI = false, bool SP2 = false>
__device__ __forceinline__ void gemm_phase(PG8_LAS unsigned char* lds, const Gemm g, const Sched& S, const Epi& E) {
    const int tid = opaque_tid(), wid = __builtin_amdgcn_readfirstlane(tid >> 6), lane = tid & 63, wr = wid >> 2, wc = wid & 3, fr = lane & 15, fq = lane >> 4;
    const int K = g.K, nt = K / BK;
    unsigned voffA[2], voffB[2];
#pragma unroll
    for (int i = 0; i < 2; ++i) { int R, C; stage_rc(tid * 16 + i * 8192, R, C); const int Rb = Epi::PERM ? ((R & ~31) + perm32(R & 31)) : R;
        voffA[i] = (unsigned)(R * g.ld + C) * 2u; voffB[i] = (unsigned)(Rb * g.ld + C) * 2u; }
    const size_t kstep = (size_t)(BK * 2);
    const size_t hstep = (size_t)HALF * g.ld * 2;
    const size_t tstep = 2 * hstep;
    const unsigned ldsw = (unsigned)wid * 1024u;
    const int aoff = lds_byte(wr * 64 + fr, fq * 8), boff = lds_byte(wc * 32 + fr, fq * 8);
#define PG8_SA(b, h) (((b) * 2 + (h)) * HTB)
#define PG8_SB(b, h) ((4 + (b) * 2 + (h)) * HTB)
#define PG8_STAGE(bufoff, gbase, voff) do { _Pragma("unroll") for (int _i = 0; _i < 2; ++_i) \
        __builtin_amdgcn_global_load_lds((const unsigned*)((const char*)(gbase) + (voff)[_i]), (PG8_LAS unsigned*)(lds + (bufoff) + ldsw + _i * 8192), 16, 0, 0); } while (0)
#define PG8_LDA(dst, b, h) do { _Pragma("unroll") for (int m = 0; m < 4; ++m) _Pragma("unroll") for (int k = 0; k < 2; ++k) dst[m][k] = *(const PG8_LAS bf16x8*)(lds + PG8_SA(b, h) + aoff + m * 2048 + k * 1024); } while (0)
#define PG8_LDB(dst, b, h) do { _Pragma("unroll") for (int n = 0; n < 2; ++n) _Pragma("unroll") for (int k = 0; k < 2; ++k) dst[n][k] = *(const PG8_LAS bf16x8*)(lds + PG8_SB(b, h) + boff + n * 2048 + k * 1024); } while (0)
#define PG8_MMA(ai, bj, At, Bt) do { __builtin_amdgcn_s_setprio(1); _Pragma("unroll") for (int m = 0; m < 4; ++m) _Pragma("unroll") for (int n = 0; n < 2; ++n) _Pragma("unroll") for (int k = 0; k < 2; ++k) \
        acc[ai][bj][m][n] = __builtin_amdgcn_mfma_f32_16x16x32_bf16(Bt[n][k], At[m][k], acc[ai][bj][m][n], 0, 0, 0); __builtin_amdgcn_s_setprio(0); } while (0)
#define PG8_WAIT_V(n) asm volatile("s_waitcnt vmcnt(" #n ")" ::: "memory")
#define PG8_WAIT_L(n) asm volatile("s_waitcnt lgkmcnt(" #n ")" ::: "memory")
#define PG8_BAR __builtin_amdgcn_s_barrier()
#define PG8_SCHED __builtin_amdgcn_sched_barrier(0)
    Unit cur, nxt; int ui = 0;
    if (!S.next(0, cur)) return;
    f32x4 acc[2][2][4][2];
#pragma unroll
    for (int a = 0; a < 2; ++a)
#pragma unroll
        for (int b = 0; b < 2; ++b)
#pragma unroll
            for (int m = 0; m < 4; ++m)
#pragma unroll
                for (int n = 0; n < 2; ++n) acc[a][b][m][n] = (f32x4){0.f, 0.f, 0.f, 0.f};
    bf16x8 At[4][2], B0[2][2], B1[2][2];
    const char* cA = (const char*)g.A + (size_t)cur.pm * tstep; const char* cB = (const char*)g.Bt + (size_t)cur.pn * tstep;
    S.a_ready(cur);
    if constexpr (SP2) {
        PG8_STAGE(PG8_SB(0, 0), cB, voffB); PG8_STAGE(PG8_SB(0, 1), cB + hstep, voffB); PG8_STAGE(PG8_SA(0, 0), cA, voffA); PG8_STAGE(PG8_SA(0, 1), cA + hstep, voffA);
        if (wr == 1) PG8_BAR;
        PG8_WAIT_V(2); PG8_BAR;
        PG8_STAGE(PG8_SB(1, 0), cB + kstep, voffB); PG8_STAGE(PG8_SA(1, 0), cA + kstep, voffA); PG8_STAGE(PG8_SB(1, 1), cB + hstep + kstep, voffB);
        PG8_WAIT_V(6); PG8_BAR;
    } else {
        PG8_STAGE(PG8_SB(0, 0), cB, voffB); PG8_STAGE(PG8_SA(0, 0), cA, voffA); PG8_STAGE(PG8_SB(0, 1), cB + hstep, voffB); PG8_STAGE(PG8_SA(0, 1), cA + hstep, voffA);
        if (wr == 1) PG8_BAR;
        PG8_WAIT_V(4); PG8_BAR;
        PG8_STAGE(PG8_SB(1, 0), cB + kstep, voffB); PG8_STAGE(PG8_SA(1, 0), cA + kstep, voffA); PG8_STAGE(PG8_SB(1, 1), cB + hstep + kstep, voffB);
        PG8_WAIT_V(6); PG8_BAR;
    }
    for (;;) {
        const bool has_next = S.next(ui + 1, nxt);
        const char* nA = has_next ? (const char*)g.A + (size_t)nxt.pm * tstep : cA; const char* nB = has_next ? (const char*)g.Bt + (size_t)nxt.pn * tstep : cB;
        for (int t = 0; t < nt; t += 2) {
            const bool last = (t == nt - 2);
            const char* a1 = cA + (size_t)(t + 1) * kstep;
            const char* a2 = last ? nA : cA + (size_t)(t + 2) * kstep; const char* b2 = last ? nB : cB + (size_t)(t + 2) * kstep;
            const char* a3 = a2 + kstep; const char* b3 = b2 + kstep;
            if (last && has_next) S.a_ready(nxt);
            if constexpr (SP2) {
            PG8_LDB(B0, 0, 0); PG8_LDB(B1, 0, 1); PG8_SCHED; PG8_LDA(At, 0, 0); PG8_STAGE(PG8_SA(1, 1), a1 + hstep, voffA);
            PG8_WAIT_V(8); PG8_WAIT_L(0); PG8_BAR; PG8_MMA(0, 0, At, B0); PG8_MMA(0, 1, At, B1); PG8_BAR; PG8_SCHED;
            PG8_LDA(At, 0, 1); PG8_STAGE(PG8_SB(0, 0), b2, voffB); PG8_STAGE(PG8_SB(0, 1), b2 + hstep, voffB); PG8_STAGE(PG8_SA(0, 0), a2, voffA);
            PG8_WAIT_V(8); PG8_WAIT_L(0); PG8_BAR; PG8_MMA(1, 0, At, B0); PG8_MMA(1, 1, At, B1); PG8_BAR; PG8_SCHED;
            PG8_LDB(B0, 1, 0); PG8_LDB(B1, 1, 1); PG8_SCHED; PG8_LDA(At, 1, 0); PG8_STAGE(PG8_SA(0, 1), a2 + hstep, voffA);
            PG8_WAIT_V(8); PG8_WAIT_L(0); PG8_BAR; PG8_MMA(0, 0, At, B0); PG8_MMA(0, 1, At, B1); PG8_BAR; PG8_SCHED;
            PG8_LDA(At, 1, 1); PG8_STAGE(PG8_SB(1, 0), b3, voffB); PG8_STAGE(PG8_SB(1, 1), b3 + hstep, voffB); PG8_STAGE(PG8_SA(1, 0), a3, voffA);
            PG8_WAIT_V(8); PG8_WAIT_L(0); PG8_BAR; PG8_MMA(1, 0, At, B0); PG8_MMA(1, 1, At, B1); PG8_BAR; PG8_SCHED;
            } else {
            PG8_LDB(B0, 0, 0); PG8_SCHED; PG8_LDA(At, 0, 0); PG8_STAGE(PG8_SA(1, 1), a1 + hstep, voffA);
            PG8_WAIT_L(8); PG8_BAR; PG8_WAIT_L(0); PG8_MMA(0, 0, At, B0); PG8_BAR; PG8_SCHED;
            PG8_LDB(B1, 0, 1); PG8_STAGE(PG8_SB(0, 0), b2, voffB);
            PG8_BAR; PG8_WAIT_L(0); PG8_MMA(0, 1, At, B1); PG8_BAR;
            PG8_LDA(At, 0, 1); PG8_STAGE(PG8_SA(0, 0), a2, voffA);
            PG8_BAR; PG8_WAIT_L(0); PG8_MMA(1, 0, At, B0); PG8_BAR; PG8_SCHED;
            PG8_STAGE(PG8_SB(0, 1), b2 + hstep, voffB);
            PG8_WAIT_V(6); PG8_BAR; PG8_MMA(1, 1, At, B1); PG8_BAR;
            PG8_LDB(B0, 1, 0); PG8_SCHED; PG8_LDA(At, 1, 0); PG8_STAGE(PG8_SA(0, 1), a2 + hstep, voffA);
            PG8_WAIT_L(8); PG8_BAR; PG8_WAIT_L(0); PG8_MMA(0, 0, At, B0); PG8_BAR; PG8_SCHED;
            PG8_LDB(B1, 1, 1); PG8_STAGE(PG8_SB(1, 0), b3, voffB);
            PG8_BAR; PG8_WAIT_L(0); PG8_MMA(0, 1, At, B1); PG8_BAR;
            PG8_LDA(At, 1, 1); PG8_STAGE(PG8_SA(1, 0), a3, voffA);
            PG8_BAR; PG8_WAIT_L(0); PG8_MMA(1, 0, At, B0); PG8_BAR; PG8_SCHED;
            PG8_STAGE(PG8_SB(1, 1), b3 + hstep, voffB);
            PG8_WAIT_V(6); PG8_BAR; PG8_MMA(1, 1, At, B1); PG8_BAR;
            }
        }
        if constexpr (ALIGN_EPI) { if (wr == 0) PG8_BAR; }
        if constexpr (!Epi::AFTER_DRAIN) { E(acc, cur, wr, wc, fr, fq); S.done(cur); }
        if (!has_next) break;
#pragma unroll
        for (int a = 0; a < 2; ++a)
#pragma unroll
            for (int b = 0; b < 2; ++b)
#pragma unroll
                for (int m = 0; m < 4; ++m)
#pragma unroll
                    for (int n = 0; n < 2; ++n) acc[a][b][m][n] = (f32x4){0.f, 0.f, 0.f, 0.f};
        cur = nxt; cA = nA; cB = nB; ++ui;
        if constexpr (ALIGN_EPI) { if (wr == 1) PG8_BAR; }
    }
    PG8_WAIT_V(0);
    if constexpr (!ALIGN_EPI) { if (wr == 0) PG8_BAR; }
    PG8_BAR;
    if constexpr (Epi::AFTER_DRAIN) { E.fused(acc, cur, wr, wc, fr, fq, lds, wid, lane); S.done(cur); }
#undef PG8_SA
#undef PG8_SB
#undef PG8_STAGE
#undef PG8_LDA
#undef PG8_LDB
#undef PG8_MMA
#undef PG8_WAIT_V
#undef PG8_WAIT_L
#undef PG8_BAR
#undef PG8_SCHED
}
}

constexpr int DM = 1024, NB = 8, SEQ = 4096, DEPTH = 4, CTXL = 256, INW = 2304, DFF = 4096;
constexpr int ML = NB * SEQ;
constexpr int MC = NB * CTXL;
constexpr int MT = ML + MC;
constexpr float EPS = 1e-6f;
constexpr float QSCALE = 0.125f * 1.4426950408889634f;

constexpr size_t MiB = 1u << 20;
constexpr size_t OFF_MOD = 0;
constexpr size_t OFF_TAB = 1 * MiB;
constexpr size_t OFF_BAR = 1 * MiB + 16 * 1024;
constexpr size_t OFF_WSP = 1 * MiB + 64 * 1024;
constexpr size_t OFF_WPT = OFF_WSP + 512 * 1024;
constexpr size_t OFF_WIN = 2 * MiB;
constexpr size_t OFF_WOUT = 20 * MiB;
constexpr size_t OFF_W1 = 28 * MiB;
constexpr size_t OFF_W2 = 60 * MiB;
constexpr size_t OFF_XC = 92 * MiB;
constexpr size_t OFF_H = 100 * MiB;
constexpr size_t OFF_Z = 168 * MiB;
constexpr size_t OFF_MIX = 321 * MiB;
constexpr size_t OFF_HID = 168 * MiB;
constexpr size_t OFF_SSQ = 440 * MiB;
constexpr size_t OFF_BIN = 443 * MiB;
constexpr size_t OFF_B1 = 444 * MiB;
constexpr size_t OFF_XL = 445 * MiB;
constexpr size_t WS_NEED = 509 * MiB;

constexpr int LDS_BYTES = 147456;
constexpr int NTHR = 512;

#define LAS __attribute__((address_space(3)))
typedef unsigned short bf16;
typedef short bf16x8 __attribute__((ext_vector_type(8)));
typedef float f32x4 __attribute__((ext_vector_type(4)));
typedef float f32x16 __attribute__((ext_vector_type(16)));
typedef unsigned u32x4 __attribute__((ext_vector_type(4)));
typedef unsigned u32x2 __attribute__((ext_vector_type(2)));
typedef short s16x4 __attribute__((ext_vector_type(4)));
typedef float f32x2_t __attribute__((ext_vector_type(2)));
typedef __bf16 bf16x2_t __attribute__((ext_vector_type(2)));
typedef _Float16 h16x4 __attribute__((ext_vector_type(4)));

__device__ __forceinline__ unsigned cvtpk(float lo, float hi) { f32x2_t v = {lo, hi}; bf16x2_t b = __builtin_convertvector(v, bf16x2_t); return __builtin_bit_cast(unsigned, b); }
__device__ __forceinline__ bf16 f2bf(float f) { return (bf16)(cvtpk(f, 0.f) & 0xffffu); }
__device__ __forceinline__ float bf2f(unsigned b) { return __uint_as_float(b << 16); }
__device__ __forceinline__ float bflo(unsigned w) { return __uint_as_float(w << 16); }
__device__ __forceinline__ float bfhi(unsigned w) { return __uint_as_float(w & 0xffff0000u); }
__device__ __forceinline__ int crow(int r, int hi) { return (r & 3) + 8 * (r >> 2) + 4 * hi; }
__device__ __forceinline__ float wave_sum(float v) {
#pragma unroll
    for (int o = 1; o < 64; o <<= 1) v += __shfl_xor(v, o);
    return v;
}

__host__ __device__ __forceinline__ int rope_perm32(int j) { return 8 * ((j & 15) >> 2) + 4 * (j >> 4) + (j & 3); }
struct Params {
    const float *x, *c, *ctx, *c_ctx, *w_ada, *b_ada, *g_mix, *g_mlp, *w_in, *lq1, *lk1, *lq2, *lk2, *g_sub, *g_v, *w_sp, *b_sp, *w_pool, *s_pool, *w_out, *w1, *w2, *g_final;
    float* out; unsigned char* ws;
};

struct EpiInProj {
    static constexpr bool PERM = true, AFTER_DRAIN = false;
    bf16* Z; const float* cosT; const float* sinT; const float* ssq; const float* bias;
    __device__ __forceinline__ void operator()(const pg8::f32x4 (&acc)[2][2][4][2], const pg8::Unit& u, int wr, int wc, int fr, int fq) const {
        const bool rope = (u.pn < 4) && (u.pm < ML / 256);
        const float sc = (u.pn < 2) ? QSCALE : 1.f;
        const int row0 = u.pm * 256 + wr * 64 + fr, col0 = u.pn * 256 + wc * 32 + 8 * fq;
        const float* bp = bias + (size_t)((u.pm < ML / 256) ? (u.pm >> 4) : 8) * INW + col0;
        f32x4 bv[2][2];
#pragma unroll
        for (int bj = 0; bj < 2; ++bj)
#pragma unroll
            for (int n = 0; n < 2; ++n) bv[bj][n] = *(const f32x4*)(bp + bj * 128 + n * 4);
#pragma unroll
        for (int ai = 0; ai < 2; ++ai)
#pragma unroll
            for (int m = 0; m < 4; ++m) {
                const int row = row0 + ai * 128 + m * 16;
                float rstd;
                { const f32x4* sp = (const f32x4*)(ssq + (size_t)row * 16); const f32x4 a = sp[0] + sp[1] + sp[2] + sp[3]; rstd = rsqrtf(((a[0] + a[1]) + (a[2] + a[3])) * (1.f / DM) + EPS); }
                f32x4 cs = {1.f, 1.f, 1.f, 1.f}, sn = {0.f, 0.f, 0.f, 0.f};
                if (rope) { const int pos = (wc & 1) ? (row & 63) : ((row >> 6) & 63); cs = *(const f32x4*)(cosT + pos * 16 + 4 * fq); sn = *(const f32x4*)(sinT + pos * 16 + 4 * fq); }
                bf16* rowp = Z + (size_t)row * INW + col0;
#pragma unroll
                for (int bj = 0; bj < 2; ++bj) {
                    const f32x4 x1 = acc[ai][bj][m][0] * rstd + bv[bj][0], x2 = acc[ai][bj][m][1] * rstd + bv[bj][1];
                    const f32x4 o1 = (x1 * cs - x2 * sn) * sc, o2 = (x2 * cs + x1 * sn) * sc;
                    *(u32x4*)(rowp + bj * 128) = (u32x4){cvtpk(o1[0], o1[1]), cvtpk(o1[2], o1[3]), cvtpk(o2[0], o2[1]), cvtpk(o2[2], o2[3])};
                }
            }
    }
};
struct EpiSqRelu {
    static constexpr bool PERM = true, AFTER_DRAIN = false;
    bf16* O; int ldc; const float* ssq; const float* bias;
    __device__ __forceinline__ void operator()(const pg8::f32x4 (&acc)[2][2][4][2], const pg8::Unit& u, int wr, int wc, int fr, int fq) const {
        const int row0 = u.pm * 256 + wr * 64 + fr, col0 = u.pn * 256 + wc * 32 + 8 * fq;
        const float* bp = bias + (size_t)((u.pm < ML / 256) ? (u.pm >> 4) : 8) * DFF + col0;
        f32x4 bv[2][2];
#pragma unroll
        for (int bj = 0; bj < 2; ++bj)
#pragma unroll
            for (int n = 0; n < 2; ++n) bv[bj][n] = *(const f32x4*)(bp + bj * 128 + n * 4);
#pragma unroll
        for (int ai = 0; ai < 2; ++ai)
#pragma unroll
            for (int m = 0; m < 4; ++m) { const int row = row0 + ai * 128 + m * 16; bf16* rowp = O + (size_t)row * ldc + col0;
                float rstd;
                { const f32x4* sp = (const f32x4*)(ssq + (size_t)row * 16); const f32x4 a = sp[0] + sp[1] + sp[2] + sp[3]; rstd = rsqrtf(((a[0] + a[1]) + (a[2] + a[3])) * (1.f / DM) + EPS); }
#pragma unroll
                for (int bj = 0; bj < 2; ++bj) {
                    f32x4 v0 = acc[ai][bj][m][0] * rstd + bv[bj][0], v1 = acc[ai][bj][m][1] * rstd + bv[bj][1];
#pragma unroll
                    for (int e = 0; e < 4; ++e) { const float a = fmaxf(v0[e], 0.f), b = fmaxf(v1[e], 0.f); v0[e] = a * a; v1[e] = b * b; }
                    u32x4 w; w.x = cvtpk(v0[0], v0[1]); w.y = cvtpk(v0[2], v0[3]); w.z = cvtpk(v1[0], v1[1]); w.w = cvtpk(v1[2], v1[3]);
                    *(u32x4*)(rowp + bj * 128) = w; } }
    }
};
#ifndef EPIRES_FENCE
#define EPIRES_FENCE
#endif
struct EpiRes {
    static constexpr bool PERM = true, AFTER_DRAIN = false;
    const void* srcL; _Float16* dstL; const void* srcC; _Float16* dstC; int src_f32; const float* gate;
    const float* nxt_g; const float* nxt_sc; bf16* XG; float* ssq;
    __device__ __forceinline__ void operator()(const pg8::f32x4 (&acc)[2][2][4][2], const pg8::Unit& u, int wr, int wc, int fr, int fq) const {
        const bool lat = u.pm < ML / 256;
        const int bidx = lat ? (u.pm >> 4) : 8;
        const float* g = gate + (size_t)bidx * 6144;
        const size_t rbase = lat ? 0 : (size_t)ML * DM;
        const float* src32 = (const float*)(lat ? srcL : srcC) - rbase; const _Float16* src16 = (const _Float16*)(lat ? srcL : srcC) - rbase;
        _Float16* dst = (lat ? dstL : dstC) - rbase;
        const int row0 = u.pm * 256 + wr * 64 + fr, col0 = u.pn * 256 + wc * 32 + 8 * fq;
        const bool has_next = nxt_g != nullptr;
        float ss[2][4];
#pragma unroll
        for (int ai = 0; ai < 2; ++ai)
#pragma unroll
            for (int m = 0; m < 4; ++m) ss[ai][m] = 0.f;
#pragma unroll
        for (int bj = 0; bj < 2; ++bj) { const int col = col0 + bj * 128;
            const f32x4 gv0 = *(const f32x4*)(g + col), gv1 = *(const f32x4*)(g + col + 4);
            f32x4 gm0 = {0.f, 0.f, 0.f, 0.f}, gm1 = {0.f, 0.f, 0.f, 0.f};
            if (has_next) { const float* sc = nxt_sc + (size_t)bidx * 6144 + col;
                gm0 = *(const f32x4*)(nxt_g + col) * (*(const f32x4*)sc + 1.f); gm1 = *(const f32x4*)(nxt_g + col + 4) * (*(const f32x4*)(sc + 4) + 1.f); }
#pragma unroll
            for (int ai = 0; ai < 2; ++ai)
#pragma unroll
                for (int m = 0; m < 4; ++m) { const size_t off = (size_t)(row0 + ai * 128 + m * 16) * DM + col;
                    f32x4 x0, x1;
                    if (src_f32) { x0 = *(const f32x4*)(src32 + off); x1 = *(const f32x4*)(src32 + off + 4); }
                    else { const u32x4 raw = *(const u32x4*)(src16 + off); const u32x2 lo = {raw[0], raw[1]}, hi2 = {raw[2], raw[3]};
                        x0 = __builtin_convertvector(__builtin_bit_cast(h16x4, lo), f32x4); x1 = __builtin_convertvector(__builtin_bit_cast(h16x4, hi2), f32x4); }
                    const f32x4 n0 = x0 + gv0 * acc[ai][bj][m][0], n1 = x1 + gv1 * acc[ai][bj][m][1];
                    { const u32x2 lo = __builtin_bit_cast(u32x2, __builtin_convertvector(n0, h16x4)), hi2 = __builtin_bit_cast(u32x2, __builtin_convertvector(n1, h16x4));
                      *(u32x4*)(dst + off) = (u32x4){lo[0], lo[1], hi2[0], hi2[1]}; }
                    if (has_next) { ss[ai][m] += ((n0[0] * n0[0] + n0[1] * n0[1]) + (n0[2] * n0[2] + n0[3] * n0[3])) + ((n1[0] * n1[0] + n1[1] * n1[1]) + (n1[2] * n1[2] + n1[3] * n1[3]));
                        const f32x4 y0 = n0 * gm0, y1 = n1 * gm1;
                        *(u32x4*)(XG + off) = (u32x4){cvtpk(y0[0], y0[1]), cvtpk(y0[2], y0[3]), cvtpk(y1[0], y1[1]), cvtpk(y1[2], y1[3])}; } }
        }
        if (has_next) {
#pragma unroll
            for (int ai = 0; ai < 2; ++ai)
#pragma unroll
                for (int m = 0; m < 4; ++m) { float v = ss[ai][m]; v += __shfl_xor(v, 16); v += __shfl_xor(v, 32);
                    if (fq == 0) ssq[(size_t)(row0 + ai * 128 + m * 16) * 16 + u.pn * 4 + wc] = v; }
        }
    }
};

struct EpiPartial {
    static constexpr bool PERM = false, AFTER_DRAIN = false;
    float* PART;
    __device__ __forceinline__ void operator()(const pg8::f32x4 (&acc)[2][2][4][2], const pg8::Unit& u, int wr, int wc, int fr, int fq) const {
        const int row0 = u.pm * 256 + wr * 64 + fr, col0 = u.pn * 256 + wc * 32 + 4 * fq;
#pragma unroll
        for (int ai = 0; ai < 2; ++ai)
#pragma unroll
            for (int m = 0; m < 4; ++m)
#pragma unroll
                for (int bj = 0; bj < 2; ++bj)
#pragma unroll
                    for (int n = 0; n < 2; ++n) *(f32x4*)(PART + (size_t)(row0 + ai * 128 + m * 16) * DM + col0 + bj * 128 + n * 16) = acc[ai][bj][m][n];
    }
};
struct OneUnit {
    pg8::Unit u0;
    __device__ __forceinline__ bool next(int i, pg8::Unit& u) const { if (i) return false; u = u0; return true; }
    __device__ __forceinline__ void a_ready(const pg8::Unit&) const {}
    __device__ __forceinline__ void done(const pg8::Unit&) const {}
};
__device__ __forceinline__ void ctx_finalize_phase(_Float16* XC, const float* PART, const float* gate8, const float* nxt_g, const float* nxt_sc8, bf16* H, float* ssq, int lane, int wave) {
    const int gw = blockIdx.x * 8 + wave, NGW = gridDim.x * 8;
    for (int row = gw; row < MC; row += NGW) {
        h16x4* xr = (h16x4*)(XC + (size_t)row * DM) + lane;
        f32x4 v[4]; float s = 0.f;
#pragma unroll
        for (int j = 0; j < 4; ++j) {
            f32x4 a = {0.f, 0.f, 0.f, 0.f};
#pragma unroll
            for (int ks = 0; ks < 8; ++ks) a += *((const f32x4*)(PART + ((size_t)ks * MC + row) * DM) + lane + 64 * j);
            v[j] = __builtin_convertvector(xr[64 * j], f32x4) + *((const f32x4*)gate8 + lane + 64 * j) * a; xr[64 * j] = __builtin_convertvector(v[j], h16x4);
            s += (v[j][0] * v[j][0] + v[j][1] * v[j][1]) + (v[j][2] * v[j][2] + v[j][3] * v[j][3]); }
        const float tot = wave_sum(s);
        u32x2* o = (u32x2*)(H + (size_t)(ML + row) * DM) + lane;
#pragma unroll
        for (int j = 0; j < 4; ++j) { const f32x4 y = v[j] * *((const f32x4*)nxt_g + lane + 64 * j) * (*((const f32x4*)nxt_sc8 + lane + 64 * j) + 1.f);
            u32x2 w; w.x = cvtpk(y[0], y[1]); w.y = cvtpk(y[2], y[3]); o[64 * j] = w; }
        if (lane < 16) ssq[(size_t)(ML + row) * 16 + lane] = (lane == 0) ? tot : 0.f;
    }
}

__device__ __forceinline__ void transpose_item(const float* W, int K, int N, bf16* WT, LAS float* scr, int item, int lane, int perm_lim = 0) {
    const int nblk = N / 32, kb = item / nblk, nb = item % nblk, k0 = 64 * kb, n0 = 32 * nb;
#pragma unroll 8
    for (int i = 0; i < 32; ++i) { const int kk = 2 * i + (lane >> 5); scr[kk * 33 + (lane & 31)] = W[(size_t)(k0 + kk) * N + n0 + (lane & 31)]; }
    asm volatile("s_waitcnt lgkmcnt(0)" ::: "memory");
    const int c = lane & 7;
#pragma unroll
    for (int j = 0; j < 4; ++j) { const int n = (lane >> 3) + 8 * j; const LAS float* s = scr + (8 * c) * 33 + n;
        u32x4 o; o.x = cvtpk(s[0 * 33], s[1 * 33]); o.y = cvtpk(s[2 * 33], s[3 * 33]); o.z = cvtpk(s[4 * 33], s[5 * 33]); o.w = cvtpk(s[6 * 33], s[7 * 33]);
        const int nn = (n0 < perm_lim) ? rope_perm32(n) : n;
        *(u32x4*)(WT + (size_t)(n0 + nn) * K + k0 + 8 * c) = o; }
    asm volatile("s_waitcnt lgkmcnt(0)" ::: "memory");
}

__device__ __forceinline__ void gemv9_item(const float* Wc, int ldw, const LAS float* vec, LAS float* red, float* outc, int ldo, const float* addb, int tid, int lane, int wave, bool perm = false);
__device__ __forceinline__ void transposes_layer(const Params& P, int l, LAS unsigned char* lds, int gw, int NGW, int wave, int lane) {
    unsigned char* ws = P.ws;
    LAS float* scr = (LAS float*)(lds + wave * 16384);
    constexpr int I_IN = (DM / 64) * (INW / 32), I_OUT = (DM / 64) * (DM / 32), I_1 = (DM / 64) * (DFF / 32), I_2 = (DFF / 64) * (DM / 32), I_P = 2;
    constexpr int PER_L = I_IN + I_OUT + I_1 + I_2 + 4 * I_P;
    for (int it = gw; it < PER_L; it += NGW) {
        int r = it;
        if (r < I_IN) { transpose_item(P.w_in + (size_t)l * DM * INW, DM, INW, (bf16*)(ws + OFF_WIN) + (size_t)l * INW * DM, scr, r, lane, 1024); continue; } r -= I_IN;
        if (r < I_OUT) { transpose_item(P.w_out + (size_t)l * DM * DM, DM, DM, (bf16*)(ws + OFF_WOUT) + (size_t)l * DM * DM, scr, r, lane); continue; } r -= I_OUT;
        if (r < I_1) { transpose_item(P.w1 + (size_t)l * DM * DFF, DM, DFF, (bf16*)(ws + OFF_W1) + (size_t)l * DFF * DM, scr, r, lane); continue; } r -= I_1;
        if (r < I_2) { transpose_item(P.w2 + (size_t)l * DFF * DM, DFF, DM, (bf16*)(ws + OFF_W2) + (size_t)l * DM * DFF, scr, r, lane); continue; } r -= I_2;
        const int g = r / I_P; r %= I_P;
        transpose_item(P.w_pool + (size_t)(l * 4 + g) * 4096, 64, 64, (bf16*)(ws + OFF_WPT) + (size_t)(l * 4 + g) * 4096, scr, r, lane);
    }
}
__device__ __forceinline__ void prologue(const Params& P, LAS unsigned char* lds, int tid, int lane, int wave) {
    unsigned char* ws = P.ws;
    const int G = gridDim.x, gw = blockIdx.x * 8 + wave, NGW = G * 8;
    transposes_layer(P, 0, lds, gw, NGW, wave, lane);
    {
        bf16* wsp = (bf16*)(ws + OFF_WSP);
        for (int i = blockIdx.x * NTHR + tid; i < DEPTH * 4 * 128 * 128 / 4; i += G * NTHR) {
            const f32x4 v = *(const f32x4*)(P.w_sp + (size_t)i * 4); u32x2 o; o.x = cvtpk(v[0], v[1]); o.y = cvtpk(v[2], v[3]); *(u32x2*)(wsp + (size_t)i * 4) = o; }
    }
    if (blockIdx.x == (unsigned)(G - 1)) {
        float* cosT = (float*)(ws + OFF_TAB); float* sinT = cosT + 1024; float* lam = cosT + 2048;
        for (int idx = tid; idx < 1024; idx += NTHR) {
            const int pos = idx >> 4, i = idx & 15;
            const float inv = __builtin_amdgcn_exp2f(-(float)i * (13.287712379549449f / 16.0f));
            const double rev0 = (double)pos * (double)inv * 0.15915494309189535; const float rev = (float)(rev0 - floor(rev0));
            cosT[idx] = __builtin_amdgcn_cosf(rev); sinT[idx] = __builtin_amdgcn_sinf(rev);
        }
        if (tid < DEPTH) {
            const int l = tid; float s1 = 0.f, s2 = 0.f;
            for (int i = 0; i < 64; ++i) { s1 += P.lq1[l * 64 + i] * P.lk1[l * 64 + i]; s2 += P.lq2[l * 64 + i] * P.lk2[l * 64 + i]; }
            const float lam_init = 0.8f - 0.6f * expf(-0.3f * (float)l);
            lam[l] = expf(s1) - expf(s2) + lam_init;
        }
    }
    __syncthreads();
    {
        LAS float* vec = (LAS float*)lds; LAS float* red = (LAS float*)(lds + 1024 * 12 * 4);
        for (int i = tid; i < 9 * 1024; i += NTHR) { const int j = i >> 10, k = i & 1023; const float v = (j < 8) ? P.c[j * 1024 + k] : P.c_ctx[k]; vec[k * 12 + j] = v / (1.f + __expf(-v)); }
        __syncthreads();
        float* mod = (float*)(ws + OFF_MOD);
        for (int it = blockIdx.x; it < DEPTH * 48; it += G) {
            const int l = it / 48, n0 = (it % 48) * 128;
            gemv9_item(P.w_ada + (size_t)l * DM * 6144 + n0, 6144, vec, red, mod + (size_t)l * 9 * 6144 + n0, 6144, P.b_ada + l * 6144 + n0, tid, lane, wave);
        }
    }
}

__device__ __forceinline__ void gemv9_item(const float* Wc  , int ldw, const LAS float* vec, LAS float* red, float* outc  , int ldo, const float* addb  , int tid, int lane, int wave, bool perm) {
    f32x2_t a[9];
#pragma unroll
    for (int j = 0; j < 9; ++j) a[j] = (f32x2_t){0.f, 0.f};
    const int k0 = wave * 128; const float* W = Wc + 2 * lane;
#pragma unroll 1
    for (int kb = 0; kb < 128; kb += 32) {
        f32x2_t w[32];
#pragma unroll
        for (int i = 0; i < 32; ++i) w[i] = *(const f32x2_t*)(W + (size_t)(k0 + kb + i) * ldw);
#pragma unroll
        for (int i = 0; i < 32; ++i) {
            if ((i & 3) == 0) asm volatile("" ::: "memory");
            const LAS f32x4* vp = (const LAS f32x4*)(vec + (k0 + kb + i) * 12); const f32x4 v0 = vp[0], v1 = vp[1], v2 = vp[2];
            a[0] += w[i] * v0[0]; a[1] += w[i] * v0[1]; a[2] += w[i] * v0[2]; a[3] += w[i] * v0[3]; a[4] += w[i] * v1[0]; a[5] += w[i] * v1[1]; a[6] += w[i] * v1[2]; a[7] += w[i] * v1[3]; a[8] += w[i] * v2[0]; }
    }
#pragma unroll
    for (int j = 0; j < 9; ++j) *(LAS f32x2_t*)(red + (wave * 9 + j) * 128 + 2 * lane) = a[j];
    __syncthreads();
    for (int idx = tid; idx < 9 * 128; idx += NTHR) { const int j = idx >> 7, ln = idx & 127; float sacc = 0.f;
#pragma unroll
        for (int w_ = 0; w_ < 8; ++w_) sacc += red[(w_ * 9 + j) * 128 + ln];
        const int lo_ = perm ? ((ln & 96) + rope_perm32(ln & 31)) : ln;
        outc[(size_t)j * ldo + lo_] = sacc + (addb ? addb[ln] : 0.f); }
    __syncthreads();
}
__device__ __forceinline__ void bias_layer(const Params& P, int l, LAS unsigned char* lds, int first, int stride, int tid, int lane, int wave) {
    unsigned char* ws = P.ws;
    const float* mod = (const float*)(ws + OFF_MOD);
    LAS float* vec = (LAS float*)lds; LAS float* red = (LAS float*)(lds + 1024 * 12 * 4);
    for (int r = first; r < 50; r += stride) {
        const bool isin = r < 18; const int cb = isin ? r : r - 18;
        const float* sh = mod + (size_t)l * 9 * 6144 + (isin ? 0 : 3) * 1024;
        for (int i = tid; i < 9 * 1024; i += NTHR) { const int j = i >> 10, k = i & 1023; vec[k * 12 + j] = sh[(size_t)j * 6144 + k]; }
        __syncthreads();
        if (isin) gemv9_item(P.w_in + (size_t)l * DM * INW + cb * 128, INW, vec, red, (float*)(ws + OFF_BIN) + (size_t)l * 9 * INW + cb * 128, INW, nullptr, tid, lane, wave, cb * 128 < 1024);
        else gemv9_item(P.w1 + (size_t)l * DM * DFF + cb * 128, DFF, vec, red, (float*)(ws + OFF_B1) + (size_t)l * 9 * DFF + cb * 128, DFF, nullptr, tid, lane, wave);
    }
}
__device__ __forceinline__ void prep_phase(const Params& P, LAS unsigned char* lds, int tid, int lane, int wave) {
    unsigned char* ws = P.ws;
    const float* mod = (const float*)(ws + OFF_MOD);
    LAS float* vec = (LAS float*)lds; LAS float* red = (LAS float*)(lds + 1024 * 12 * 4);
    for (int l = 0; l < DEPTH; ++l) bias_layer(P, l, lds, (blockIdx.x + 192 * l) % gridDim.x, gridDim.x, tid, lane, wave);
    const int gw = blockIdx.x * 8 + wave, NGW = gridDim.x * 8;
    bf16* H = (bf16*)(ws + OFF_H); float* ssq = (float*)(ws + OFF_SSQ);
    f32x4 gv[4];
#pragma unroll
    for (int j = 0; j < 4; ++j) gv[j] = *((const f32x4*)P.g_mix + lane + 64 * j);
    for (int row = gw; row < MT; row += NGW) {
        const float* xr = row < ML ? P.x + (size_t)row * DM : P.ctx + (size_t)(row - ML) * DM;
        const int bidx = row < ML ? (row >> 12) : 8;
        const float* sc = mod + (size_t)bidx * 6144 + 1024;
        f32x4 v[4]; float s = 0.f;
#pragma unroll
        for (int j = 0; j < 4; ++j) { v[j] = *((const f32x4*)xr + lane + 64 * j); s += (v[j][0] * v[j][0] + v[j][1] * v[j][1]) + (v[j][2] * v[j][2] + v[j][3] * v[j][3]); }
        const float tot = wave_sum(s);
        u32x2* o = (u32x2*)(H + (size_t)row * DM) + lane;
#pragma unroll
        for (int j = 0; j < 4; ++j) { const f32x4 scv = *((const f32x4*)sc + lane + 64 * j);
            const f32x4 y = v[j] * gv[j] * (scv + 1.f); u32x2 w; w.x = cvtpk(y[0], y[1]); w.y = cvtpk(y[2], y[3]); o[64 * j] = w; }
        if (lane < 16) ssq[(size_t)row * 16 + lane] = (lane == 0) ? tot : 0.f;
    }
}
__device__ __forceinline__ void final_norm_phase(const _Float16* xl, float* out, const float* g, int lane, int wave) {
    const int gw = blockIdx.x * 8 + wave, NGW = gridDim.x * 8;
    f32x4 gv[4];
#pragma unroll
    for (int j = 0; j < 4; ++j) gv[j] = *((const f32x4*)g + lane + 64 * j);
    for (int row = gw; row < ML; row += NGW) {
        const h16x4* xr = (const h16x4*)(xl + (size_t)row * DM) + lane; f32x4* orow = (f32x4*)(out + (size_t)row * DM) + lane;
        f32x4 v[4]; float s = 0.f;
#pragma unroll
        for (int j = 0; j < 4; ++j) { v[j] = __builtin_convertvector(xr[64 * j], f32x4); s += (v[j][0] * v[j][0] + v[j][1] * v[j][1]) + (v[j][2] * v[j][2] + v[j][3] * v[j][3]); }
        const float rstd = rsqrtf(wave_sum(s) * (1.f / DM) + EPS);
#pragma unroll
        for (int j = 0; j < 4; ++j) orow[64 * j] = v[j] * rstd * gv[j];
    }
}

constexpr int AT_KV = 0;
constexpr int AT_WS = 65536;
constexpr int AT_EX = 67584;
constexpr float THR = 8.f;

__device__ __forceinline__ void glds16(const void* gsrc, unsigned lds_dst) { unsigned keep;
    asm volatile("s_mov_b32 %0, m0\n\ts_mov_b32 m0, %2\n\ts_nop 0\n\tglobal_load_lds_dwordx4 %1, off\n\ts_mov_b32 m0, %0" : "=&s"(keep) : "v"(gsrc), "s"(lds_dst) : "memory"); }
__device__ __forceinline__ s16x4 vtr(const LAS unsigned char* p) { return __builtin_bit_cast(s16x4, __builtin_amdgcn_ds_read_tr16_b64_v4i16((LAS s16x4*)p)); }

__device__ __forceinline__ void attn_unit(const bf16* Z, bf16* MIX, int qrow0, int h, int ka, int nta, int kb, int ntb, float lam, float post, const float* gsub, LAS unsigned char* lds, int tid, int lane, int wave) {
    const int r32 = lane & 31, hi = lane >> 5, comp = wave >> 2, rg = wave & 3;
    const int NT = nta + ntb;
    const unsigned lds0 = (unsigned)(size_t)lds;
    unsigned ksrc[2], vsrc[2], kdst[2], vdst[2];
#pragma unroll
    for (int u = 0; u < 2; ++u) { const int bk = wave + 8 * u;
        { const int cmp = bk >> 3, j = bk & 7, kl = lane >> 3, c = (lane & 7) ^ kl; ksrc[u] = (unsigned)((8 * j + kl) * INW + 512 + h * 128 + cmp * 64 + c * 8); kdst[u] = (unsigned)(cmp * 8192 + j * 1024); }
        { const int db = bk >> 2, p = bk & 3, kl = lane >> 2, ch = lane & 3; vsrc[u] = (unsigned)((16 * p + kl) * INW + 1024 + h * 128 + db * 32 + ch * 8); vdst[u] = (unsigned)(32768 + db * 4096 + p * 1024); } }
#define AT_ROW(t) (((t) < nta) ? ka + 64 * (t) : kb + 64 * ((t) - nta))
#define AT_DMAK(t, buf) do { const bf16* rb_ = Z + (size_t)AT_ROW(t) * INW; _Pragma("unroll") for (int u = 0; u < 2; ++u) glds16(rb_ + ksrc[u], (unsigned)__builtin_amdgcn_readfirstlane(lds0 + (buf) * 16384 + kdst[u])); } while (0)
#define AT_DMAV(t, buf) do { const bf16* rb_ = Z + (size_t)AT_ROW(t) * INW; _Pragma("unroll") for (int u = 0; u < 2; ++u) glds16(rb_ + vsrc[u], (unsigned)__builtin_amdgcn_readfirstlane(lds0 + (buf) * 16384 + vdst[u])); } while (0)
#define AT_WAITBAR() do { asm volatile("s_waitcnt vmcnt(0)" ::: "memory"); __syncthreads(); } while (0)
    AT_DMAK(0, 0); AT_DMAK(1, 1); AT_DMAV(0, 0);
    bf16x8 qr[4];
    { const bf16* qp = Z + (size_t)(qrow0 + rg * 32 + r32) * INW + h * 128 + comp * 64 + hi * 8;
#pragma unroll
      for (int d0 = 0; d0 < 4; ++d0) qr[d0] = *(const bf16x8*)(qp + d0 * 16); }
    AT_WAITBAR();
    LAS float* wsf = (LAS float*)(lds + AT_WS) + wave * 64;
    f32x16 o[4];
#pragma unroll
    for (int d = 0; d < 4; ++d) o[d] = f32x16{};
    f32x16 negm = f32x16{};
    float mhat = 0.f, lsum = 0.f;
    const int koff = comp * 8192 + r32 * 128;
    const int voff = 32768 + ((lane >> 4) & 1) * 32 + (lane & 3) * 8 + (4 * hi + ((lane & 15) >> 2)) * 64;
    f32x16 C0, C1, P0, P1;
#define AT_ROWMAX(rm) do { float a_ = fmaxf(fmaxf(C0[0], C0[1]), C1[0]), b_ = fmaxf(fmaxf(C0[2], C0[3]), C1[1]); a_ = fmaxf(fmaxf(a_, C1[2]), C1[3]); \
        _Pragma("unroll") for (int r = 4; r < 16; r += 4) { a_ = fmaxf(fmaxf(a_, C0[r]), C0[r + 1]); b_ = fmaxf(fmaxf(b_, C0[r + 2]), C0[r + 3]); a_ = fmaxf(fmaxf(a_, C1[r]), C1[r + 1]); b_ = fmaxf(fmaxf(b_, C1[r + 2]), C1[r + 3]); } \
        rm = fmaxf(a_, b_); rm = fmaxf(rm, __shfl_xor(rm, 32)); } while (0)
    {
        const LAS unsigned char* kb_ = lds;
        C0 = negm; C1 = negm;
#pragma unroll
        for (int d0 = 0; d0 < 4; ++d0) { const int sw = (((2 * d0 + hi) ^ (r32 & 7)) << 4);
            C0 = __builtin_amdgcn_mfma_f32_32x32x16_bf16(*(const LAS bf16x8*)(kb_ + koff + sw), qr[d0], C0, 0, 0, 0);
            C1 = __builtin_amdgcn_mfma_f32_32x32x16_bf16(*(const LAS bf16x8*)(kb_ + koff + 32 * 128 + sw), qr[d0], C1, 0, 0, 0); }
        float rm; AT_ROWMAX(rm);
        mhat = rm;
#pragma unroll
        for (int r = 0; r < 16; ++r) { P0[r] = __builtin_amdgcn_exp2f(C0[r] - rm); P1[r] = __builtin_amdgcn_exp2f(C1[r] - rm); negm[r] = -mhat; }
    }
    __syncthreads();
    if (wave >= 4) __builtin_amdgcn_s_setprio(1);
    for (int t = 1; t < NT; ++t) {
        const LAS unsigned char* kb_ = lds + (t & 1) * 16384;
        const LAS unsigned char* vb_ = lds + ((t - 1) & 1) * 16384 + voff;
        if (t + 1 < NT) AT_DMAK(t + 1, (t + 1) & 1);
        AT_DMAV(t, t & 1);
        u32x4 pw[4]; float sacc = 0.f;
        C0 = negm; C1 = negm;
#pragma unroll
        for (int d0 = 0; d0 < 4; ++d0) { const int sw = (((2 * d0 + hi) ^ (r32 & 7)) << 4);
            C0 = __builtin_amdgcn_mfma_f32_32x32x16_bf16(*(const LAS bf16x8*)(kb_ + koff + sw), qr[d0], C0, 0, 0, 0);
            sacc += (P0[4 * d0] + P0[4 * d0 + 1]) + (P0[4 * d0 + 2] + P0[4 * d0 + 3]);
            pw[d0 >> 1][(d0 & 1) * 2] = cvtpk(P0[4 * d0], P0[4 * d0 + 1]); pw[d0 >> 1][(d0 & 1) * 2 + 1] = cvtpk(P0[4 * d0 + 2], P0[4 * d0 + 3]);
            C1 = __builtin_amdgcn_mfma_f32_32x32x16_bf16(*(const LAS bf16x8*)(kb_ + koff + 32 * 128 + sw), qr[d0], C1, 0, 0, 0);
            sacc += (P1[4 * d0] + P1[4 * d0 + 1]) + (P1[4 * d0 + 2] + P1[4 * d0 + 3]);
            pw[2 + (d0 >> 1)][(d0 & 1) * 2] = cvtpk(P1[4 * d0], P1[4 * d0 + 1]); pw[2 + (d0 >> 1)][(d0 & 1) * 2 + 1] = cvtpk(P1[4 * d0 + 2], P1[4 * d0 + 3]); }
        lsum += sacc;
        __builtin_amdgcn_sched_group_barrier(0x008, 2, 1);
#pragma unroll
        for (int i_ = 0; i_ < 6; ++i_) { __builtin_amdgcn_sched_group_barrier(0x400, 5, 1); __builtin_amdgcn_sched_group_barrier(0x008, 1, 1); }
        __builtin_amdgcn_sched_group_barrier(0x400, 2, 1);
        float rm; AT_ROWMAX(rm);
        bool resc = false;
        if (__any(rm > THR)) {
            const float dl = fmaxf(rm, 0.f);
            mhat += dl;
#pragma unroll
            for (int r = 0; r < 16; ++r) { C0[r] -= dl; C1[r] -= dl; negm[r] = -mhat; }
            const float f = __builtin_amdgcn_exp2f(-dl);
            lsum *= f;
            if (hi == 0) wsf[r32] = f;
            resc = true;
        }
#pragma unroll
        for (int d0 = 0; d0 < 4; ++d0)
#pragma unroll
            for (int ks = 0; ks < 4; ++ks) {
                const s16x4 lo = vtr(vb_ + d0 * 4096 + ks * 1024), hh = vtr(vb_ + d0 * 4096 + ks * 1024 + 512);
                const bf16x8 vf = (bf16x8){lo[0], lo[1], lo[2], lo[3], hh[0], hh[1], hh[2], hh[3]};
                o[d0] = __builtin_amdgcn_mfma_f32_32x32x16_bf16(__builtin_bit_cast(bf16x8, pw[ks]), vf, o[d0], 0, 0, 0);
                const int e = (d0 * 4 + ks);
                if (e < 8) { P0[2 * e] = __builtin_amdgcn_exp2f(C0[2 * e]); P0[2 * e + 1] = __builtin_amdgcn_exp2f(C0[2 * e + 1]); }
                else { P1[2 * e - 16] = __builtin_amdgcn_exp2f(C1[2 * e - 16]); P1[2 * e - 15] = __builtin_amdgcn_exp2f(C1[2 * e - 15]); }
            }
        if (resc) {
#pragma unroll
            for (int r = 0; r < 16; ++r) { const float fr_ = wsf[crow(r, hi)];
#pragma unroll
                for (int d = 0; d < 4; ++d) o[d][r] *= fr_; }
        }
        AT_WAITBAR();
    }
    __builtin_amdgcn_s_setprio(0);
    {
        const LAS unsigned char* vb_ = lds + ((NT - 1) & 1) * 16384 + voff;
        float sacc = 0.f;
#pragma unroll
        for (int r = 0; r < 16; ++r) sacc += P0[r] + P1[r];
        lsum += sacc;
        u32x4 pw[4];
        pw[0] = (u32x4){cvtpk(P0[0], P0[1]), cvtpk(P0[2], P0[3]), cvtpk(P0[4], P0[5]), cvtpk(P0[6], P0[7])};
        pw[1] = (u32x4){cvtpk(P0[8], P0[9]), cvtpk(P0[10], P0[11]), cvtpk(P0[12], P0[13]), cvtpk(P0[14], P0[15])};
        pw[2] = (u32x4){cvtpk(P1[0], P1[1]), cvtpk(P1[2], P1[3]), cvtpk(P1[4], P1[5]), cvtpk(P1[6], P1[7])};
        pw[3] = (u32x4){cvtpk(P1[8], P1[9]), cvtpk(P1[10], P1[11]), cvtpk(P1[12], P1[13]), cvtpk(P1[14], P1[15])};
#pragma unroll
        for (int d0 = 0; d0 < 4; ++d0)
#pragma unroll
            for (int ks = 0; ks < 4; ++ks) {
                const s16x4 lo = vtr(vb_ + d0 * 4096 + ks * 1024), hh = vtr(vb_ + d0 * 4096 + ks * 1024 + 512);
                const bf16x8 vf = (bf16x8){lo[0], lo[1], lo[2], lo[3], hh[0], hh[1], hh[2], hh[3]};
                o[d0] = __builtin_amdgcn_mfma_f32_32x32x16_bf16(__builtin_bit_cast(bf16x8, pw[ks]), vf, o[d0], 0, 0, 0);
            }
    }
#undef AT_ROW
#undef AT_DMAK
#undef AT_DMAV
#undef AT_WAITBAR
#undef AT_ROWMAX
    lsum += __shfl_xor(lsum, 32);
    const float inv = (comp == 0 ? 1.f : lam) / lsum;
    if (hi == 0) wsf[r32] = inv;
    asm volatile("s_waitcnt lgkmcnt(0)" ::: "memory");
    float rl[16];
#pragma unroll
    for (int r = 0; r < 16; ++r) rl[r] = wsf[crow(r, hi)];
    LAS float* ex = (LAS float*)(lds + AT_EX) + rg * 4096 + lane;
    if (comp == 1) {
#pragma unroll
        for (int d = 0; d < 4; ++d)
#pragma unroll
            for (int r = 0; r < 16; ++r) ex[(d * 16 + r) * 64] = o[d][r] * rl[r];
    }
    __syncthreads();
    if (comp == 0) {
        float ss[16];
#pragma unroll
        for (int r = 0; r < 16; ++r) { float s = 0.f;
#pragma unroll
            for (int d = 0; d < 4; ++d) { const float a = o[d][r] * rl[r] - ex[(d * 16 + r) * 64]; o[d][r] = a; s += a * a; }
            ss[r] = s; }
#pragma unroll
        for (int r = 0; r < 16; ++r) {
#pragma unroll
            for (int off = 1; off < 32; off <<= 1) ss[r] += __shfl_xor(ss[r], off);
            ss[r] = rsqrtf(ss[r] * (1.f / 128.f) + EPS) * post; }
        LAS bf16* stg = (LAS bf16*)((LAS float*)(lds + AT_EX) + rg * 4096);
#pragma unroll
        for (int d = 0; d < 4; ++d) { const float gs = gsub[d * 32 + r32];
#pragma unroll
            for (int r = 0; r < 16; ++r) stg[crow(r, hi) * 136 + d * 32 + r32] = f2bf(o[d][r] * ss[r] * gs); }
#pragma unroll
        for (int i = 0; i < 8; ++i) { const int idx = lane + 64 * i, row = idx >> 4, ch = idx & 15;
            const u32x4 v = *(const LAS u32x4*)(stg + row * 136 + ch * 8);
            *(u32x4*)(MIX + (size_t)(qrow0 + rg * 32 + row) * DM + h * 128 + ch * 8) = v; }
    }
    __syncthreads();
}

__device__ __forceinline__ void gate_item(const bf16* Z, bf16* MIX, int tok0, int g, const bf16* Wsp_lg, const float* bsp_lg, const float* gv_l, LAS unsigned char* lds, int tid, int lane, int wave) {
    LAS bf16* vnT = (LAS bf16*)lds;
    {
        const int q = tid >> 2, cq = tid & 3;
        const bf16* src = Z + (size_t)(tok0 + q) * INW + 1792 + g * 64 + cq * 16;
        const u32x4 a = *(const u32x4*)src, b = *(const u32x4*)(src + 8);
        float x[16];
#pragma unroll
        for (int i = 0; i < 4; ++i) { x[2 * i] = bflo(a[i]); x[2 * i + 1] = bfhi(a[i]); x[8 + 2 * i] = bflo(b[i]); x[8 + 2 * i + 1] = bfhi(b[i]); }
        float ss = 0.f;
#pragma unroll
        for (int i = 0; i < 16; ++i) ss += x[i] * x[i];
        ss += __shfl_xor(ss, 1); ss += __shfl_xor(ss, 2);
        const float rstd = rsqrtf(ss * (1.f / 64.f) + EPS);
#pragma unroll
        for (int i = 0; i < 16; ++i) vnT[(cq * 16 + i) * 136 + q] = f2bf(x[i] * rstd * gv_l[g * 64 + cq * 16 + i]);
    }
    __syncthreads();
    const int r32 = lane & 31, hi = lane >> 5, pb = wave & 3, cb = wave >> 2;
    f32x16 acc = f32x16{};
#pragma unroll
    for (int s = 0; s < 8; ++s) {
        const bf16x8 A = *(const bf16x8*)(Wsp_lg + (size_t)(pb * 32 + r32) * 128 + 16 * s + 8 * hi);
        const bf16x8 B = *(const LAS bf16x8*)(vnT + (cb * 32 + r32) * 136 + 16 * s + 8 * hi);
        acc = __builtin_amdgcn_mfma_f32_32x32x16_bf16(A, B, acc, 0, 0, 0);
    }
    const int c = cb * 32 + r32;
#pragma unroll
    for (int r = 0; r < 16; ++r) { const int p = pb * 32 + crow(r, hi); const size_t tok = (size_t)(tok0 + p);
        const float u = bf2f(Z[tok * INW + 1536 + g * 64 + c]);
        MIX[tok * DM + 512 + g * 64 + c] = f2bf((acc[r] + bsp_lg[p]) * u); }
    __syncthreads();
}

__device__ __forceinline__ void pool_item(const bf16* Z, bf16* MIX, int tok0, int g, const bf16* WpT_lg, const float* sp_l, LAS unsigned char* lds, int tid, int lane, int wave) {
    LAS bf16* pt = (LAS bf16*)lds;
    LAS bf16* dT = (LAS bf16*)(lds + 144 * 72 * 2);
    const int TS = tok0 < ML ? SEQ : CTXL, pos0 = tok0 & (TS - 1);
    for (int idx = tid; idx < 144 * 8; idx += NTHR) { const int row = idx >> 3, ch = idx & 7, pos = pos0 - 8 + row;
        u32x4 v = {0u, 0u, 0u, 0u};
        if (pos >= 0 && pos < TS) v = *(const u32x4*)(Z + (size_t)(tok0 - 8 + row) * INW + 2048 + g * 64 + ch * 8);
        *(LAS u32x4*)(pt + row * 72 + ch * 8) = v; }
    __syncthreads();
    {
        const int t = tid >> 2, cq = tid & 3, w = 2 << g, half = w >> 1, pos = pos0 + t;
        const int lo = max(pos - half, 0), hi_ = min(pos + half, TS);
        const float rc = 1.f / (float)(hi_ - lo);
        float sum[16];
#pragma unroll
        for (int i = 0; i < 16; ++i) sum[i] = 0.f;
        for (int k = 0; k < w; ++k) { const LAS bf16* rp = pt + (t + 8 - half + k) * 72 + cq * 16;
            const u32x4 a = *(const LAS u32x4*)rp, b = *(const LAS u32x4*)(rp + 8);
#pragma unroll
            for (int i = 0; i < 4; ++i) { sum[2 * i] += bflo(a[i]); sum[2 * i + 1] += bfhi(a[i]); sum[8 + 2 * i] += bflo(b[i]); sum[8 + 2 * i + 1] += bfhi(b[i]); } }
        const LAS bf16* xp = pt + (t + 8) * 72 + cq * 16;
        const u32x4 a = *(const LAS u32x4*)xp, b = *(const LAS u32x4*)(xp + 8);
        float x[16];
#pragma unroll
        for (int i = 0; i < 4; ++i) { x[2 * i] = bflo(a[i]); x[2 * i + 1] = bfhi(a[i]); x[8 + 2 * i] = bflo(b[i]); x[8 + 2 * i + 1] = bfhi(b[i]); }
        u32x4 o0, o1;
#pragma unroll
        for (int i = 0; i < 4; ++i) { o0[i] = cvtpk(sum[2 * i] * rc - x[2 * i], sum[2 * i + 1] * rc - x[2 * i + 1]); o1[i] = cvtpk(sum[8 + 2 * i] * rc - x[8 + 2 * i], sum[8 + 2 * i + 1] * rc - x[8 + 2 * i + 1]); }
        *(LAS u32x4*)(dT + t * 72 + cq * 16) = o0; *(LAS u32x4*)(dT + t * 72 + cq * 16 + 8) = o1;
    }
    __syncthreads();
    const int r32 = lane & 31, hi = lane >> 5, tb = wave & 3, eb = wave >> 2;
    f32x16 acc = f32x16{};
#pragma unroll
    for (int s = 0; s < 4; ++s) {
        const bf16x8 A = *(const LAS bf16x8*)(dT + (tb * 32 + r32) * 72 + 16 * s + 8 * hi);
        const bf16x8 B = *(const bf16x8*)(WpT_lg + (size_t)(eb * 32 + r32) * 64 + 16 * s + 8 * hi);
        acc = __builtin_amdgcn_mfma_f32_32x32x16_bf16(A, B, acc, 0, 0, 0);
    }
    const int e = eb * 32 + r32; const float sp = sp_l[g * 64 + e];
#pragma unroll
    for (int r = 0; r < 16; ++r) { const size_t tok = (size_t)(tok0 + tb * 32 + crow(r, hi)); MIX[tok * DM + 768 + g * 64 + e] = f2bf(acc[r] * sp); }
    __syncthreads();
}

__device__ __forceinline__ void small_item(const bf16* Z, bf16* MIX, int tok0, int g, const bf16* Wsp_lg, const float* bsp_lg, const float* gv_l, const bf16* WpT_lg, const float* sp_l, LAS unsigned char* lds, int tid, int lane, int wave) {
    LAS bf16* vnT = (LAS bf16*)lds;
    LAS bf16* pt = (LAS bf16*)(lds + 17408);
    LAS bf16* dT = (LAS bf16*)(lds + 38144);
    LAS bf16* uT = (LAS bf16*)(lds + 56576);
    LAS bf16* og = (LAS bf16*)(lds + 75008);
    LAS bf16* op = (LAS bf16*)(lds + 93440);
    const int TS = tok0 < ML ? SEQ : CTXL, pos0 = tok0 & (TS - 1);
    const int r32 = lane & 31, hi = lane >> 5, rb = wave & 3, cb = wave >> 2;
    const int q = tid >> 2, cq = tid & 3;
    const bf16* zrow = Z + (size_t)(tok0 + q) * INW + g * 64 + cq * 16;
    const u32x4 ga = *(const u32x4*)(zrow + 1792), gb = *(const u32x4*)(zrow + 1792 + 8);
    const u32x4 ua = *(const u32x4*)(zrow + 1536), ub = *(const u32x4*)(zrow + 1536 + 8);
    u32x4 pv[3]; int prow[3];
#pragma unroll
    for (int i = 0; i < 3; ++i) { const int idx = tid + NTHR * i; prow[i] = idx >> 3; const int ch = idx & 7, pos = pos0 - 8 + prow[i];
        pv[i] = (u32x4){0u, 0u, 0u, 0u};
        if (idx < 144 * 8 && pos >= 0 && pos < TS) pv[i] = *(const u32x4*)(Z + (size_t)(tok0 - 8 + prow[i]) * INW + 2048 + g * 64 + ch * 8); }
    bf16x8 Ag[8];
#pragma unroll
    for (int s_ = 0; s_ < 8; ++s_) Ag[s_] = *(const bf16x8*)(Wsp_lg + (size_t)(rb * 32 + r32) * 128 + 16 * s_ + 8 * hi);
    {
        float x[16];
#pragma unroll
        for (int i = 0; i < 4; ++i) { x[2 * i] = bflo(ga[i]); x[2 * i + 1] = bfhi(ga[i]); x[8 + 2 * i] = bflo(gb[i]); x[8 + 2 * i + 1] = bfhi(gb[i]); }
        float ss = 0.f;
#pragma unroll
        for (int i = 0; i < 16; ++i) ss += x[i] * x[i];
        ss += __shfl_xor(ss, 1); ss += __shfl_xor(ss, 2);
        const float rstd = rsqrtf(ss * (1.f / 64.f) + EPS);
#pragma unroll
        for (int i = 0; i < 16; ++i) vnT[(cq * 16 + i) * 136 + q] = f2bf(x[i] * rstd * gv_l[g * 64 + cq * 16 + i]);
        *(LAS u32x4*)(uT + q * 72 + cq * 16) = ua; *(LAS u32x4*)(uT + q * 72 + cq * 16 + 8) = ub;
#pragma unroll
        for (int i = 0; i < 3; ++i) { const int idx = tid + NTHR * i; if (idx < 144 * 8) *(LAS u32x4*)(pt + prow[i] * 72 + (idx & 7) * 8) = pv[i]; }
    }
    __syncthreads();
    {
        const int t = q, w = 2 << g, half = w >> 1, pos = pos0 + t;
        const int lo = max(pos - half, 0), hi_ = min(pos + half, TS);
        const float rc = 1.f / (float)(hi_ - lo);
        float sum[16];
#pragma unroll
        for (int i = 0; i < 16; ++i) sum[i] = 0.f;
        for (int k = 0; k < w; ++k) { const LAS bf16* rp = pt + (t + 8 - half + k) * 72 + cq * 16;
            const u32x4 a = *(const LAS u32x4*)rp, b = *(const LAS u32x4*)(rp + 8);
#pragma unroll
            for (int i = 0; i < 4; ++i) { sum[2 * i] += bflo(a[i]); sum[2 * i + 1] += bfhi(a[i]); sum[8 + 2 * i] += bflo(b[i]); sum[8 + 2 * i + 1] += bfhi(b[i]); } }
        const LAS bf16* xp = pt + (t + 8) * 72 + cq * 16;
        const u32x4 a = *(const LAS u32x4*)xp, b = *(const LAS u32x4*)(xp + 8);
        float x[16];
#pragma unroll
        for (int i = 0; i < 4; ++i) { x[2 * i] = bflo(a[i]); x[2 * i + 1] = bfhi(a[i]); x[8 + 2 * i] = bflo(b[i]); x[8 + 2 * i + 1] = bfhi(b[i]); }
        u32x4 o0, o1;
#pragma unroll
        for (int i = 0; i < 4; ++i) { o0[i] = cvtpk(sum[2 * i] * rc - x[2 * i], sum[2 * i + 1] * rc - x[2 * i + 1]); o1[i] = cvtpk(sum[8 + 2 * i] * rc - x[8 + 2 * i], sum[8 + 2 * i + 1] * rc - x[8 + 2 * i + 1]); }
        *(LAS u32x4*)(dT + t * 72 + cq * 16) = o0; *(LAS u32x4*)(dT + t * 72 + cq * 16 + 8) = o1;
    }
    {
        f32x16 acc = f32x16{};
#pragma unroll
        for (int s_ = 0; s_ < 8; ++s_) { const bf16x8 B = *(const LAS bf16x8*)(vnT + (cb * 32 + r32) * 136 + 16 * s_ + 8 * hi); acc = __builtin_amdgcn_mfma_f32_32x32x16_bf16(Ag[s_], B, acc, 0, 0, 0); }
        const int c = cb * 32 + r32;
#pragma unroll
        for (int r = 0; r < 16; ++r) { const int p = rb * 32 + crow(r, hi);
            og[p * 72 + c] = f2bf((acc[r] + bsp_lg[p]) * bf2f(uT[p * 72 + c])); }
    }
    __syncthreads();
    {
        f32x16 acc = f32x16{};
#pragma unroll
        for (int s_ = 0; s_ < 4; ++s_) {
            const bf16x8 A = *(const LAS bf16x8*)(dT + (rb * 32 + r32) * 72 + 16 * s_ + 8 * hi);
            const bf16x8 B = *(const bf16x8*)(WpT_lg + (size_t)(cb * 32 + r32) * 64 + 16 * s_ + 8 * hi);
            acc = __builtin_amdgcn_mfma_f32_32x32x16_bf16(A, B, acc, 0, 0, 0); }
        const int e = cb * 32 + r32; const float sp = sp_l[g * 64 + e];
#pragma unroll
        for (int r = 0; r < 16; ++r) op[(rb * 32 + crow(r, hi)) * 72 + e] = f2bf(acc[r] * sp);
    }
    __syncthreads();
    {
        bf16* mrow = MIX + (size_t)(tok0 + q) * DM + g * 64 + cq * 16;
        *(u32x4*)(mrow + 512) = *(const LAS u32x4*)(og + q * 72 + cq * 16); *(u32x4*)(mrow + 512 + 8) = *(const LAS u32x4*)(og + q * 72 + cq * 16 + 8);
        *(u32x4*)(mrow + 768) = *(const LAS u32x4*)(op + q * 72 + cq * 16); *(u32x4*)(mrow + 768 + 8) = *(const LAS u32x4*)(op + q * 72 + cq * 16 + 8);
    }
}

#define XB_TMO      128
#define XB_XCNT(j)  (256  + 64 * (j))
#define XB_XSUB(j)  (1280 + 64 * (j))
#define XB_XGEN(j)  (2304 + 64 * (j))
#define XB_TOP      3328
#define XB_TOPGEN   3392
#define XCD_BAR_WORDS 3456
#define XB_SPIN_CAP (1u << 18)

__device__ __forceinline__ unsigned xb_ld(unsigned* p)              { return __hip_atomic_load(p, __ATOMIC_RELAXED, __HIP_MEMORY_SCOPE_AGENT); }
__device__ __forceinline__ unsigned xb_add(unsigned* p, unsigned v) { return __hip_atomic_fetch_add(p, v, __ATOMIC_RELAXED, __HIP_MEMORY_SCOPE_AGENT); }
__device__ __forceinline__ unsigned xb_xcc_id() { return (unsigned)__builtin_amdgcn_s_getreg((3 << 11) | 20) & 0xFu; }
#define XB_SPIN(cond, bar) do { unsigned _sp = 0; while (cond) { __builtin_amdgcn_s_sleep(1); \
    if ((++_sp & 255u) == 0u) { if (xb_ld(&(bar)[XB_TMO])) break; if (_sp > XB_SPIN_CAP) { atomicAdd(&(bar)[XB_TMO], 1u); break; } } } } while (0)

struct XcdBarrier {
    unsigned* bar; unsigned x;
    volatile LAS unsigned* st;
};

__device__ __forceinline__ XcdBarrier xcd_barrier_post(unsigned* bar, volatile LAS unsigned* st) {
    XcdBarrier b; b.bar = bar; b.x = xb_xcc_id(); b.st = st;
    if (threadIdx.x == 0) (void)xb_add(&bar[XB_XCNT(b.x)], 1u);
    return b;
}
__device__ __forceinline__ void xcd_barrier_complete(unsigned* bar, unsigned x, unsigned& nloc, unsigned& nx) {
    const unsigned G = gridDim.x * gridDim.y * gridDim.z;
    unsigned sum, cnt, mine, sp = 0u;
    for (;;) {
        sum = 0u; cnt = 0u; mine = 0u;
#pragma unroll
        for (unsigned j = 0; j < 16; ++j) { const unsigned c = xb_ld(&bar[XB_XCNT(j)]); sum += c; cnt += (c > 0u) ? 1u : 0u; mine = (j == x) ? c : mine; }
        if (sum == G) break;
        __builtin_amdgcn_s_sleep(1);
        if ((++sp & 255u) == 0u) { if (xb_ld(&bar[XB_TMO])) break; if (sp > XB_SPIN_CAP) { atomicAdd(&bar[XB_TMO], 1u); break; } }
    }
    nloc = mine > 0u ? mine : 1u; nx = cnt > 0u ? cnt : 1u;
}

__device__ __forceinline__ void xcd_barrier(const XcdBarrier& b) {
    asm volatile("s_waitcnt vmcnt(0)" ::: "memory");
    __syncthreads();
    if (threadIdx.x == 0) {
        unsigned* bar = b.bar;
        __builtin_amdgcn_s_waitcnt(0);
        unsigned nloc = b.st[0], nx = b.st[1];
        if (nloc == 0u) { xcd_barrier_complete(bar, b.x, nloc, nx); b.st[0] = nloc; b.st[1] = nx; }
        const unsigned old = xb_add(&bar[XB_XSUB(b.x)], 1u);
        const unsigned gen = old / nloc;
        if (old + 1u == (gen + 1u) * nloc) {
            __builtin_amdgcn_fence(__ATOMIC_RELEASE, "agent");
            asm volatile("s_waitcnt vmcnt(0)" ::: "memory");
            const unsigned og = xb_add(&bar[XB_TOP], 1u);
            const unsigned tg = og / nx;
            if (og + 1u == (tg + 1u) * nx) xb_add(&bar[XB_TOPGEN], 1u);
            else XB_SPIN(xb_ld(&bar[XB_TOPGEN]) == tg, bar);
            __builtin_amdgcn_fence(__ATOMIC_ACQUIRE, "agent");
            xb_add(&bar[XB_XGEN(b.x)], 1u);
            asm volatile("s_waitcnt vmcnt(0)" ::: "memory");
        } else {
            XB_SPIN(xb_ld(&bar[XB_XGEN(b.x)]) == gen, bar);
            __builtin_amdgcn_fence(__ATOMIC_ACQUIRE, "agent");
            asm volatile("s_waitcnt vmcnt(0)" ::: "memory");
        }
    }
    __syncthreads();
}

__global__ void __launch_bounds__(NTHR, 2) fwd_megakernel(Params P) {
    extern __shared__ __attribute__((aligned(16))) unsigned char lds_raw[];
    LAS unsigned char* lds = (LAS unsigned char*)lds_raw;
    cg::grid_group grid = cg::this_grid();
    const int G = gridDim.x, bid = blockIdx.x;
#define TLW const int tid = opaque_tid(), lane = tid & 63, wave = __builtin_amdgcn_readfirstlane(tid >> 6); (void)tid; (void)lane; (void)wave
    unsigned char* ws = P.ws;
    float* mod = (float*)(ws + OFF_MOD);
    const float* cosT = (const float*)(ws + OFF_TAB); const float* sinT = cosT + 1024; const float* lamv = cosT + 2048;
    bf16* H = (bf16*)(ws + OFF_H); bf16* Z = (bf16*)(ws + OFF_Z); bf16* MIX = (bf16*)(ws + OFF_MIX); bf16* HID = (bf16*)(ws + OFF_HID);
    _Float16* XC = (_Float16*)(ws + OFF_XC); _Float16* XL = (_Float16*)(ws + OFF_XL);

    {   TLW;
        if (bid == 0) for (int i = tid; i < XCD_BAR_WORDS; i += NTHR) ((unsigned*)(ws + OFF_BAR))[i] = 0u;
        if (tid < 16) ((LAS unsigned*)(lds + LDS_BYTES - 64))[tid] = 0u;
        __syncthreads();
    }
#ifndef NO_PRO
    { TLW; prologue(P, lds, tid, lane, wave); }
#endif
    grid.sync();
    const XcdBarrier xbar = xcd_barrier_post((unsigned*)(ws + OFF_BAR), (volatile LAS unsigned*)(lds + LDS_BYTES - 64));
#define GRID_BAR() xcd_barrier(xbar)
    float* SSQ = (float*)(ws + OFF_SSQ);
    { TLW; prep_phase(P, lds, tid, lane, wave); }
    GRID_BAR();

    for (int l = 0; l < DEPTH; ++l) {
        const bool last = (l == DEPTH - 1);
        const void* xl_src = (l == 0) ? (const void*)P.x : (const void*)XL;
        const void* xc_src = (l == 0) ? (const void*)P.ctx : (const void*)XC;
        const float* mod_l = mod + (size_t)l * 9 * 6144;
        {
            pg8::Gemm g{H, (const bf16*)(ws + OFF_WIN) + (size_t)l * INW * DM, MT, INW, DM, DM}; pg8::StaticOrder S; S.init(MT, INW, G, bid);
            EpiInProj E{Z, cosT, sinT, SSQ, (const float*)(ws + OFF_BIN) + (size_t)l * 9 * INW};
#ifndef NO_G1
            pg8::gemm_phase<EpiInProj, pg8::StaticOrder, true, true>(lds, g, S, E);
#endif
        }
        GRID_BAR();
        {
            TLW;
            const float lam = lamv[l];
            const float lam_init = 0.8f - 0.6f * expf(-0.3f * (float)l);
            const float post = 1.f - lam_init;
            const float* gsub = P.g_sub + l * 128;
            const int n_lat = NB * 4 * (SEQ / 128);
            const int n_ctx = last ? 0 : NB * 4 * (CTXL / 128);
#ifndef NO_ATTN
            const int vcu = (G % 8 == 0) ? (bid % 8) * (G / 8) + bid / 8 : bid;
            for (int u = vcu; u < n_lat + n_ctx; u += G) {
                if (u < n_lat) { const int b = u >> 7, h = (u >> 5) & 3, qb = u & 31;
                    attn_unit(Z, MIX, b * SEQ + qb * 128, h, ML + b * CTXL, CTXL / 64, b * SEQ, SEQ / 64, lam, post, gsub, lds, tid, lane, wave);
                } else { const int v = u - n_lat, b = v >> 3, h = (v >> 1) & 3, qb = v & 1;
                    attn_unit(Z, MIX, ML + b * CTXL + qb * 128, h, ML + b * CTXL, CTXL / 64, 0, 0, lam, post, gsub, lds, tid, lane, wave); }
            }
#endif
#ifndef NO_SMALL
            const int nblk = (last ? ML : MT) / 128;
            for (int it = bid; it < nblk * 4; it += G) {
                const int tb = it >> 2, g = it & 3;
                small_item(Z, MIX, tb * 128, g, (const bf16*)(ws + OFF_WSP) + (size_t)(l * 4 + g) * 16384, P.b_sp + (l * 4 + g) * 128, P.g_v + l * 256,
                           (const bf16*)(ws + OFF_WPT) + (size_t)(l * 4 + g) * 4096, P.s_pool + l * 256, lds, tid, lane, wave);
            }
#endif
        }
        GRID_BAR();
        const int Mrows = last ? ML : MT;
        {
            pg8::Gemm g{MIX, (const bf16*)(ws + OFF_WOUT) + (size_t)l * DM * DM, Mrows, DM, DM, DM}; pg8::StaticOrder S; S.init(Mrows, DM, G, bid);
            EpiRes E{xl_src, XL, xc_src, XC, (l == 0) ? 1 : 0, mod_l + 2 * 1024, P.g_mlp + l * DM, mod_l + 4 * 1024, H, SSQ};
#ifndef NO_G2
            pg8::gemm_phase<EpiRes, pg8::StaticOrder, true, true>(lds, g, S, E);
#endif
        }
        if (!last) {
            TLW; __syncthreads();
            if (G == 256) { if (bid >= 32) transposes_layer(P, l + 1, lds, (bid - 32) * 8 + wave, 224 * 8, wave, lane); }
            else transposes_layer(P, l + 1, lds, bid * 8 + wave, G * 8, wave, lane);
        }
        GRID_BAR();
        {
            pg8::Gemm g{H, (const bf16*)(ws + OFF_W1) + (size_t)l * DFF * DM, Mrows, DFF, DM, DM}; pg8::StaticOrder S; S.init(Mrows, DFF, G, bid);
            EpiSqRelu E{HID, DFF, SSQ, (const float*)(ws + OFF_B1) + (size_t)l * 9 * DFF};
#ifndef NO_G3
            pg8::gemm_phase<EpiSqRelu, pg8::StaticOrder, true, true>(lds, g, S, E);
#endif
        }
        GRID_BAR();
        {
            pg8::Gemm g{HID, (const bf16*)(ws + OFF_W2) + (size_t)l * DM * DFF, ML, DM, DFF, DFF}; pg8::StaticOrder S; S.init(ML, DM, G, bid);
            EpiRes E{XL, XL, XC, XC, 0, mod_l + 5 * 1024, last ? (const float*)nullptr : P.g_mix + (l + 1) * DM, mod_l + 9 * 6144 + 1 * 1024, H, SSQ};
#ifndef NO_G4
            pg8::gemm_phase<EpiRes, pg8::StaticOrder, true, true>(lds, g, S, E);
#endif
        }
        if (!last) {
            for (int su = bid; su < 256; su += G) {
                const int tile = su >> 3, ks = su & 7;
                pg8::Gemm g{HID + (size_t)ML * DFF + ks * 512, (const bf16*)(ws + OFF_W2) + (size_t)l * DM * DFF + ks * 512, MC, DM, 512, DFF};
                OneUnit S{{tile >> 2, tile & 3}};
                EpiPartial E{P.out + (size_t)ks * MC * DM};
                pg8::gemm_phase<EpiPartial, OneUnit, false, true>(lds, g, S, E);
            }
            GRID_BAR();
            { TLW; ctx_finalize_phase(XC, (const float*)P.out, mod_l + 8 * 6144 + 5 * 1024, P.g_mix + (l + 1) * DM, mod_l + 9 * 6144 + 8 * 6144 + 1 * 1024, H, SSQ, lane, wave); }
        }
        GRID_BAR();
    }
    { TLW; final_norm_phase(XL, P.out, P.g_final, lane, wave); }
}

extern "C" void kernel_launch(void* const* d_in, const int* in_sizes, int n_in, void* d_out, int out_size, void* d_ws, size_t ws_size, hipStream_t stream) {
    static int grid_blocks = 0;
    if (grid_blocks == 0) {
        if (n_in != 23 || ws_size < WS_NEED) { fprintf(stderr, "kernel_launch: unexpected n_in %d or ws_size %zu (need %zu)\n", n_in, ws_size, (size_t)WS_NEED); grid_blocks = -1; return; }
        int dev = 0, cus = 0, per_cu = 0;
        hipGetDevice(&dev);
        hipDeviceGetAttribute(&cus, hipDeviceAttributeMultiprocessorCount, dev);
        if (hipFuncSetAttribute((const void*)fwd_megakernel, hipFuncAttributeMaxDynamicSharedMemorySize, LDS_BYTES) != hipSuccess) { fprintf(stderr, "kernel_launch: hipFuncSetAttribute failed\n"); grid_blocks = -1; return; }
        hipOccupancyMaxActiveBlocksPerMultiprocessor(&per_cu, (const void*)fwd_megakernel, NTHR, LDS_BYTES);
        if (per_cu < 1) { fprintf(stderr, "kernel_launch: occupancy query says %d blocks per CU\n", per_cu); per_cu = 1; }
        (void)hipGetLastError();
        grid_blocks = cus * per_cu;
    }
    if (grid_blocks < 0) return;
    Params p{};
    const float** pp = (const float**)&p;
    for (int i = 0; i < 23; ++i) pp[i] = (const float*)d_in[i];
    p.out = (float*)d_out; p.ws = (unsigned char*)d_ws;
    void* args[] = {&p};
    hipError_t e = hipLaunchCooperativeKernel((const void*)fwd_megakernel, dim3(grid_blocks), dim3(NTHR), args, LDS_BYTES, stream);
    if (e != hipSuccess) fprintf(stderr, "cooperative launch failed: %s (grid %d)\n", hipGetErrorString(e), grid_blocks);
}
```

```cpp
#include <hip/hip_runtime.h>
#include <hip/hip_cooperative_groups.h>
#include <cstdio>
#include <cstdint>
namespace cg = cooperative_groups;
__device__ __forceinline__ int opaque_tid() { int t = threadIdx.x; asm volatile("" : "+v"(t)); return t; }
namespace pg8 {
#define PG8_LAS __attribute__((address_space(3)))
typedef unsigned short bf16_t;
typedef short bf16x8 __attribute__((ext_vector_type(8)));
typedef float f32x4 __attribute__((ext_vector_type(4)));
typedef unsigned u32x4 __attribute__((ext_vector_type(4)));
constexpr int BM = 256, BK = 64, HALF = 128, HTB = HALF * BK * 2  , STAGE_BYTES = 8 * HTB, NXCD = 8, WGM = 8;

__host__ __device__ __forceinline__ int lds_byte(int r, int c) { const int st = (r >> 4) * 2 + (c >> 5), rr = r & 15, cc = c & 31, ob = rr * 64 + cc * 2; return st * 1024 + (ob ^ (((ob >> 9) & 1) << 5)); }
__host__ __device__ __forceinline__ void stage_rc(int b, int& R, int& C) { const int st = b / 1024, sb = b % 1024, swz = sb ^ (((sb >> 9) & 1) << 5); R = (st >> 1) * 16 + swz / 64; C = (st & 1) * 32 + (swz % 64) / 2; }
__host__ __device__ __forceinline__ int perm32(int rho) { const int n = rho >> 4, i = rho & 15; return 8 * (i >> 2) + 4 * n + (i & 3); }

struct Unit { int pm, pn; };
struct Gemm { const bf16_t* A; const bf16_t* Bt; int M, N, K, ld; };

struct StaticOrder {
    int nM, nN, nwg, G, c;
    __host__ __device__ void init(int M, int N, int G_, int c_) { nM = M / BM; nN = N / BM; nwg = nM * nN; G = G_; c = c_; }
    __host__ __device__ bool next(int i, Unit& u) const {
        const long L = (long)i * G + c; if (L >= nwg) return false;
        int wgid = (int)L; { const int q = nwg / NXCD, r = nwg % NXCD, xcd = wgid % NXCD, off = wgid / NXCD; wgid = (xcd < r ? xcd * (q + 1) : r * (q + 1) + (xcd - r) * q) + off; }
        const int nig = WGM * nN, gid = wgid / nig, fm = gid * WGM, gsz = (nM - fm) < WGM ? (nM - fm) : WGM;
        u.pm = fm + ((wgid % nig) % gsz); u.pn = (wgid % nig) / gsz; return true;
    }
    __device__ __forceinline__ void a_ready(const Unit&) const {}
    __device__ __forceinline__ void done(const Unit&) const {}
};

__device__ __forceinline__ unsigned cvt_pk_bf16(float lo, float hi) { unsigned r; asm volatile("v_cvt_pk_bf16_f32 %0, %1, %2" : "=v"(r) : "v"(lo), "v"(hi)); return r; }
typedef float f32x2 __attribute__((ext_vector_type(2)));
__device__ __forceinline__ f32x2 gelu_pk(f32x2 v) {
    const f32x2 av = __builtin_elementwise_abs(v), d = av * 0.2316418882f + 1.0f;
    f32x2 t; t.x = __builtin_amdgcn_rcpf(d.x); t.y = __builtin_amdgcn_rcpf(d.y);
    f32x2 q = t * 0.5307027145f + (-0.7265760135f); q = q * t + 0.7107068705f; q = q * t + (-0.142248368f); q = q * t + 0.127414796f; q = q * t;
    const f32x2 s = (v * v) * (-0.72134752044f);
    f32x2 e; e.x = __builtin_amdgcn_exp2f(s.x); e.y = __builtin_amdgcn_exp2f(s.y);
    const f32x2 m = v * (q * e), r = v - m;
    f32x2 o; o.x = v.x < 0.f ? m.x : r.x; o.y = v.y < 0.f ? m.y : r.y; return o;
}

template <int ACT  > struct EpiBf16 {
    static constexpr bool PERM = true, AFTER_DRAIN = false; static_assert(ACT == 0 || ACT == 1, "EpiBf16: ACT is 0 (none) or 1 (gelu_pk)");
    bf16_t* O; int ldc; const float* bias; int split_cols; size_t split_stride; float scale0;
    __device__ __forceinline__ void operator()(const f32x4 (&acc)[2][2][4][2], const Unit& u, int wr, int wc, int fr, int fq) const {
        const int row0 = u.pm * BM + wr * 64 + fr; int colt = u.pn * BM; bf16_t* base = O;
        float sc = 1.f; if (split_cols) { const int t = colt / split_cols; base += (size_t)t * split_stride; colt -= t * split_cols; if (t == 0) sc = scale0; }
        const int col0 = colt + wc * 32 + 8 * fq, bcol0 = u.pn * BM + wc * 32 + 8 * fq;
        f32x4 bv[2][2];
#pragma unroll
        for (int bj = 0; bj < 2; ++bj)
#pragma unroll
            for (int n = 0; n < 2; ++n) bv[bj][n] = bias ? *(const f32x4*)(bias + bcol0 + bj * HALF + 4 * n) : (f32x4){0.f, 0.f, 0.f, 0.f};
#pragma unroll
        for (int ai = 0; ai < 2; ++ai)
#pragma unroll
            for (int m = 0; m < 4; ++m) { bf16_t* rowp = base + (size_t)(row0 + ai * HALF + m * 16) * ldc + col0;
#pragma unroll
                for (int bj = 0; bj < 2; ++bj) { f32x4 v0 = acc[ai][bj][m][0] + bv[bj][0], v1 = acc[ai][bj][m][1] + bv[bj][1];
                    if (ACT == 1) { f32x2 a = gelu_pk((f32x2){v0[0], v0[1]}), b = gelu_pk((f32x2){v0[2], v0[3]}), c = gelu_pk((f32x2){v1[0], v1[1]}), d = gelu_pk((f32x2){v1[2], v1[3]});
                        v0 = (f32x4){a.x, a.y, b.x, b.y}; v1 = (f32x4){c.x, c.y, d.x, d.y}; }
                    v0 = v0 * sc; v1 = v1 * sc; u32x4 w; w.x = cvt_pk_bf16(v0[0], v0[1]); w.y = cvt_pk_bf16(v0[2], v0[3]); w.z = cvt_pk_bf16(v1[0], v1[1]); w.w = cvt_pk_bf16(v1[2], v1[3]);
                    *(u32x4*)(rowp + bj * HALF) = w; } }
    }
};
template <class Epi, class Sched, bool ALIGN_EPI = false, bool SP2 = false>
__device__ __forceinline__ void gemm_phase(PG8_LAS unsigned char* lds, const Gemm g, const Sched& S, const Epi& E) {
    const int tid = opaque_tid(), wid = __builtin_amdgcn_readfirstlane(tid >> 6), lane = tid & 63, wr = wid >> 2, wc = wid & 3, fr = lane & 15, fq = lane >> 4;
    const int K = g.K, nt = K / BK;
    unsigned voffA[2], voffB[2];
#pragma unroll
    for (int i = 0; i < 2; ++i) { int R, C; stage_rc(tid * 16 + i * 8192, R, C); const int Rb = Epi::PERM ? ((R & ~31) + perm32(R & 31)) : R;
        voffA[i] = (unsigned)(R * g.ld + C) * 2u; voffB[i] = (unsigned)(Rb * g.ld + C) * 2u; }
    const size_t kstep = (size_t)(BK * 2);
    const size_t hstep = (size_t)HALF * g.ld * 2;
    const size_t tstep = 2 * hstep;
    const unsigned ldsw = (unsigned)wid * 1024u;
    const int aoff = lds_byte(wr * 64 + fr, fq * 8), boff = lds_byte(wc * 32 + fr, fq * 8);
#define PG8_SA(b, h) (((b) * 2 + (h)) * HTB)
#define PG8_SB(b, h) ((4 + (b) * 2 + (h)) * HTB)
#define PG8_STAGE(bufoff, gbase, voff) do { _Pragma("unroll") for (int _i = 0; _i < 2; ++_i) \
        __builtin_amdgcn_global_load_lds((const unsigned*)((const char*)(gbase) + (voff)[_i]), (PG8_LAS unsigned*)(lds + (bufoff) + ldsw + _i * 8192), 16, 0, 0); } while (0)
#define PG8_LDA(dst, b, h) do { _Pragma("unroll") for (int m = 0; m < 4; ++m) _Pragma("unroll") for (int k = 0; k < 2; ++k) dst[m][k] = *(const PG8_LAS bf16x8*)(lds + PG8_SA(b, h) + aoff + m * 2048 + k * 1024); } while (0)
#define PG8_LDB(dst, b, h) do { _Pragma("unroll") for (int n = 0; n < 2; ++n) _Pragma("unroll") for (int k = 0; k < 2; ++k) dst[n][k] = *(const PG8_LAS bf16x8*)(lds + PG8_SB(b, h) + boff + n * 2048 + k * 1024); } while (0)
#define PG8_MMA(ai, bj, At, Bt) do { __builtin_amdgcn_s_setprio(1); _Pragma("unroll") for (int m = 0; m < 4; ++m) _Pragma("unroll") for (int n = 0; n < 2; ++n) _Pragma("unroll") for (int k = 0; k < 2; ++k) \
        acc[ai][bj][m][n] = __builtin_amdgcn_mfma_f32_16x16x32_bf16(Bt[n][k], At[m][k], acc[ai][bj][m][n], 0, 0, 0); __builtin_amdgcn_s_setprio(0); } while (0)
#define PG8_WAIT_V(n) asm volatile("s_waitcnt vmcnt(" #n ")" ::: "memory")
#define PG8_WAIT_L(n) asm volatile("s_waitcnt lgkmcnt(" #n ")" ::: "memory")
#define PG8_BAR __builtin_amdgcn_s_barrier()
#define PG8_SCHED __builtin_amdgcn_sched_barrier(0)
    Unit cur, nxt; int ui = 0;
    if (!S.next(0, cur)) return;
    f32x4 acc[2][2][4][2];
#pragma unroll
    for (int a = 0; a < 2; ++a)
#pragma unroll
        for (int b = 0; b < 2; ++b)
#pragma unroll
            for (int m = 0; m < 4; ++m)
#pragma unroll
                for (int n = 0; n < 2; ++n) acc[a][b][m][n] = (f32x4){0.f, 0.f, 0.f, 0.f};
    bf16x8 At[4][2], B0[2][2], B1[2][2];
    const char* cA = (const char*)g.A + (size_t)cur.pm * tstep; const char* cB = (const char*)g.Bt + (size_t)cur.pn * tstep;
    S.a_ready(cur);
    if constexpr (SP2) {
        PG8_STAGE(PG8_SB(0, 0), cB, voffB); PG8_STAGE(PG8_SB(0, 1), cB + hstep, voffB); PG8_STAGE(PG8_SA(0, 0), cA, voffA); PG8_STAGE(PG8_SA(0, 1), cA + hstep, voffA);
        if (wr == 1) PG8_BAR;
        PG8_WAIT_V(2); PG8_BAR;
        PG8_STAGE(PG8_SB(1, 0), cB + kstep, voffB); PG8_STAGE(PG8_SA(1, 0), cA + kstep, voffA); PG8_STAGE(PG8_SB(1, 1), cB + hstep + kstep, voffB);
        PG8_WAIT_V(6); PG8_BAR;
    } else {
        PG8_STAGE(PG8_SB(0, 0), cB, voffB); PG8_STAGE(PG8_SA(0, 0), cA, voffA); PG8_STAGE(PG8_SB(0, 1), cB + hstep, voffB); PG8_STAGE(PG8_SA(0, 1), cA + hstep, voffA);
        if (wr == 1) PG8_BAR;
        PG8_WAIT_V(4); PG8_BAR;
        PG8_STAGE(PG8_SB(1, 0), cB + kstep, voffB); PG8_STAGE(PG8_SA(1, 0), cA + kstep, voffA); PG8_STAGE(PG8_SB(1, 1), cB + hstep + kstep, voffB);
        PG8_WAIT_V(6); PG8_BAR;
    }
    for (;;) {
        const bool has_next = S.next(ui + 1, nxt);
        const char* nA = has_next ? (const char*)g.A + (size_t)nxt.pm * tstep : cA; const char* nB = has_next ? (const char*)g.Bt + (size_t)nxt.pn * tstep : cB;
        for (int t = 0; t < nt; t += 2) {
            const bool last = (t == nt - 2);
            const char* a1 = cA + (size_t)(t + 1) * kstep;
            const char* a2 = last ? nA : cA + (size_t)(t + 2) * kstep; const char* b2 = last ? nB : cB + (size_t)(t + 2) * kstep;
            const char* a3 = a2 + kstep; const char* b3 = b2 + kstep;
            if (last && has_next) S.a_ready(nxt);
            if constexpr (SP2) {
            PG8_LDB(B0, 0, 0); PG8_LDB(B1, 0, 1); PG8_SCHED; PG8_LDA(At, 0, 0); PG8_STAGE(PG8_SA(1, 1), a1 + hstep, voffA);
            PG8_WAIT_V(8); PG8_WAIT_L(0); PG8_BAR; PG8_MMA(0, 0, At, B0); PG8_MMA(0, 1, At, B1); PG8_BAR; PG8_SCHED;
            PG8_LDA(At, 0, 1); PG8_STAGE(PG8_SB(0, 0), b2, voffB); PG8_STAGE(PG8_SB(0, 1), b2 + hstep, voffB); PG8_STAGE(PG8_SA(0, 0), a2, voffA);
            PG8_WAIT_V(8); PG8_WAIT_L(0); PG8_BAR; PG8_MMA(1, 0, At, B0); PG8_MMA(1, 1, At, B1); PG8_BAR; PG8_SCHED;
            PG8_LDB(B0, 1, 0); PG8_LDB(B1, 1, 1); PG8_SCHED; PG8_LDA(At, 1, 0); PG8_STAGE(PG8_SA(0, 1), a2 + hstep, voffA);
            PG8_WAIT_V(8); PG8_WAIT_L(0); PG8_BAR; PG8_MMA(0, 0, At, B0); PG8_MMA(0, 1, At, B1); PG8_BAR; PG8_SCHED;
            PG8_LDA(At, 1, 1); PG8_STAGE(PG8_SB(1, 0), b3, voffB); PG8_STAGE(PG8_SB(1, 1), b3 + hstep, voffB); PG8_STAGE(PG8_SA(1, 0), a3, voffA);
            PG8_WAIT_V(8); PG8_WAIT_L(0); PG8_BAR; PG8_MMA(1, 0, At, B0); PG8_MMA(1, 1, At, B1); PG8_BAR; PG8_SCHED;
            } else {
            PG8_LDB(B0, 0, 0); PG8_SCHED; PG8_LDA(At, 0, 0); PG8_STAGE(PG8_SA(1, 1), a1 + hstep, voffA);
            PG8_WAIT_L(8); PG8_BAR; PG8_WAIT_L(0); PG8_MMA(0, 0, At, B0); PG8_BAR; PG8_SCHED;
            PG8_LDB(B1, 0, 1); PG8_STAGE(PG8_SB(0, 0), b2, voffB);
            PG8_BAR; PG8_WAIT_L(0); PG8_MMA(0, 1, At, B1); PG8_BAR;
            PG8_LDA(At, 0, 1); PG8_STAGE(PG8_SA(0, 0), a2, voffA);
            PG8_BAR; PG8_WAIT_L(0); PG8_MMA(1, 0, At, B0); PG8_BAR; PG8_SCHED;
            PG8_STAGE(PG8_SB(0, 1), b2 + hstep, voffB);
            PG8_WAIT_V(6); PG8_BAR; PG8_MMA(1, 1, At, B1); PG8_BAR;
            PG8_LDB(B0, 1, 0); PG8_SCHED; PG8_LDA(At, 1, 0); PG8_STAGE(PG8_SA(0, 1), a2 + hstep, voffA);
            PG8_WAIT_L(8); PG8_BAR; PG8_WAIT_L(0); PG8_MMA(0, 0, At, B0); PG8_BAR; PG8_SCHED;
            PG8_LDB(B1, 1, 1); PG8_STAGE(PG8_SB(1, 0), b3, voffB);
            PG8_BAR; PG8_WAIT_L(0); PG8_MMA(0, 1, At, B1); PG8_BAR;
            PG8_LDA(At, 1, 1); PG8_STAGE(PG8_SA(1, 0), a3, voffA);
            PG8_BAR; PG8_WAIT_L(0); PG8_MMA(1, 0, At, B0); PG8_BAR; PG8_SCHED;
            PG8_STAGE(PG8_SB(1, 1), b3 + hstep, voffB);
            PG8_WAIT_V(6); PG8_BAR; PG8_MMA(1, 1, At, B1); PG8_BAR;
            }
        }
        if constexpr (ALIGN_EPI) { if (wr == 0) PG8_BAR; }
        if constexpr (!Epi::AFTER_DRAIN) { E(acc, cur, wr, wc, fr, fq); S.done(cur); }
        if (!has_next) break;
#pragma unroll
        for (int a = 0; a < 2; ++a)
#pragma unroll
            for (int b = 0; b < 2; ++b)
#pragma unroll
                for (int m = 0; m < 4; ++m)
#pragma unroll
                    for (int n = 0; n < 2; ++n) acc[a][b][m][n] = (f32x4){0.f, 0.f, 0.f, 0.f};
        cur = nxt; cA = nA; cB = nB; ++ui;
        if constexpr (ALIGN_EPI) { if (wr == 1) PG8_BAR; }
    }
    PG8_WAIT_V(0);
    if constexpr (!ALIGN_EPI) { if (wr == 0) PG8_BAR; }
    PG8_BAR;
    if constexpr (Epi::AFTER_DRAIN) { E.fused(acc, cur, wr, wc, fr, fq, lds, wid, lane); S.done(cur); }
#undef PG8_SA
#undef PG8_SB
#undef PG8_STAGE
#undef PG8_LDA
#undef PG8_LDB
#undef PG8_MMA
#undef PG8_WAIT_V
#undef PG8_WAIT_L
#undef PG8_BAR
#undef PG8_SCHED
}
}

constexpr int DM = 1024, NB = 8, SEQ = 4096, DEPTH = 4, CTXL = 256, INW = 2304, DFF = 4096;
constexpr int ML = NB * SEQ;
constexpr int MC = NB * CTXL;
constexpr int MT = ML + MC;
constexpr float EPS = 1e-6f;
constexpr float QSCALE = 0.125f * 1.4426950408889634f;

constexpr size_t MiB = 1u << 20;
constexpr size_t OFF_MOD = 0;
constexpr size_t OFF_TAB = 1 * MiB;
constexpr size_t OFF_BAR = 1 * MiB + 16 * 1024;
constexpr size_t OFF_WSP = 1 * MiB + 64 * 1024;
constexpr size_t OFF_WPT = OFF_WSP + 512 * 1024;
constexpr size_t OFF_WIN = 2 * MiB;
constexpr size_t OFF_WOUT = 20 * MiB;
constexpr size_t OFF_W1 = 28 * MiB;
constexpr size_t OFF_W2 = 60 * MiB;
constexpr size_t OFF_XC = 92 * MiB;
constexpr size_t OFF_H = 100 * MiB;
constexpr size_t OFF_Z = 168 * MiB;
constexpr size_t OFF_MIX = 321 * MiB;
constexpr size_t OFF_HID = 168 * MiB;
constexpr size_t OFF_SSQ = 440 * MiB;
constexpr size_t OFF_BIN = 443 * MiB;
constexpr size_t OFF_B1 = 444 * MiB;
constexpr size_t OFF_XL = 445 * MiB;
constexpr size_t WS_NEED = 509 * MiB;

constexpr int LDS_BYTES = 147456;
constexpr int NTHR = 512;

#define LAS __attribute__((address_space(3)))
typedef unsigned short bf16;
typedef short bf16x8 __attribute__((ext_vector_type(8)));
typedef float f32x4 __attribute__((ext_vector_type(4)));
typedef float f32x16 __attribute__((ext_vector_type(16)));
typedef unsigned u32x4 __attribute__((ext_vector_type(4)));
typedef unsigned u32x2 __attribute__((ext_vector_type(2)));
typedef short s16x4 __attribute__((ext_vector_type(4)));
typedef float f32x2_t __attribute__((ext_vector_type(2)));
typedef __bf16 bf16x2_t __attribute__((ext_vector_type(2)));
typedef _Float16 h16x4 __attribute__((ext_vector_type(4)));

__device__ __forceinline__ unsigned cvtpk(float lo, float hi) { f32x2_t v = {lo, hi}; bf16x2_t b = __builtin_convertvector(v, bf16x2_t); return __builtin_bit_cast(unsigned, b); }
__device__ __forceinline__ bf16 f2bf(float f) { return (bf16)(cvtpk(f, 0.f) & 0xffffu); }
__device__ __forceinline__ float bf2f(unsigned b) { return __uint_as_float(b << 16); }
__device__ __forceinline__ float bflo(unsigned w) { return __uint_as_float(w << 16); }
__device__ __forceinline__ float bfhi(unsigned w) { return __uint_as_float(w & 0xffff0000u); }
__device__ __forceinline__ int crow(int r, int hi) { return (r & 3) + 8 * (r >> 2) + 4 * hi; }
__device__ __forceinline__ float wave_sum(float v) {
#pragma unroll
    for (int o = 1; o < 64; o <<= 1) v += __shfl_xor(v, o);
    return v;
}

__host__ __device__ __forceinline__ int rope_perm32(int j) { return 8 * ((j & 15) >> 2) + 4 * (j >> 4) + (j & 3); }
struct Params {
    const float *x, *c, *ctx, *c_ctx, *w_ada, *b_ada, *g_mix, *g_mlp, *w_in, *lq1, *lk1, *lq2, *lk2, *g_sub, *g_v, *w_sp, *b_sp, *w_pool, *s_pool, *w_out, *w1, *w2, *g_final;
    float* out; unsigned char* ws;
};

struct EpiInProj {
    static constexpr bool PERM = true, AFTER_DRAIN = false;
    bf16* Z; const float* cosT; const float* sinT; const float* ssq; const float* bias;
    __device__ __forceinline__ void operator()(const pg8::f32x4 (&acc)[2][2][4][2], const pg8::Unit& u, int wr, int wc, int fr, int fq) const {
        const bool rope = (u.pn < 4) && (u.pm < ML / 256);
        const float sc = (u.pn < 2) ? QSCALE : 1.f;
        const int row0 = u.pm * 256 + wr * 64 + fr, col0 = u.pn * 256 + wc * 32 + 8 * fq;
        const float* bp = bias + (size_t)((u.pm < ML / 256) ? (u.pm >> 4) : 8) * INW + col0;
        f32x4 bv[2][2];
#pragma unroll
        for (int bj = 0; bj < 2; ++bj)
#pragma unroll
            for (int n = 0; n < 2; ++n) bv[bj][n] = *(const f32x4*)(bp + bj * 128 + n * 4);
#pragma unroll
        for (int ai = 0; ai < 2; ++ai)
#pragma unroll
            for (int m = 0; m < 4; ++m) {
                const int row = row0 + ai * 128 + m * 16;
                float rstd;
                { const f32x4* sp = (const f32x4*)(ssq + (size_t)row * 16); const f32x4 a = sp[0] + sp[1] + sp[2] + sp[3]; rstd = rsqrtf(((a[0] + a[1]) + (a[2] + a[3])) * (1.f / DM) + EPS); }
                f32x4 cs = {1.f, 1.f, 1.f, 1.f}, sn = {0.f, 0.f, 0.f, 0.f};
                if (rope) { const int pos = (wc & 1) ? (row & 63) : ((row >> 6) & 63); cs = *(const f32x4*)(cosT + pos * 16 + 4 * fq); sn = *(const f32x4*)(sinT + pos * 16 + 4 * fq); }
                bf16* rowp = Z + (size_t)row * INW + col0;
#pragma unroll
                for (int bj = 0; bj < 2; ++bj) {
                    const f32x4 x1 = acc[ai][bj][m][0] * rstd + bv[bj][0], x2 = acc[ai][bj][m][1] * rstd + bv[bj][1];
                    const f32x4 o1 = (x1 * cs - x2 * sn) * sc, o2 = (x2 * cs + x1 * sn) * sc;
                    *(u32x4*)(rowp + bj * 128) = (u32x4){cvtpk(o1[0], o1[1]), cvtpk(o1[2], o1[3]), cvtpk(o2[0], o2[1]), cvtpk(o2[2], o2[3])};
                }
            }
    }
};
struct EpiSqRelu {
    static constexpr bool PERM = true, AFTER_DRAIN = false;
    bf16* O; int ldc; const float* ssq; const float* bias;
    __device__ __forceinline__ void operator()(const pg8::f32x4 (&acc)[2][2][4][2], const pg8::Unit& u, int wr, int wc, int fr, int fq) const {
        const int row0 = u.pm * 256 + wr * 64 + fr, col0 = u.pn * 256 + wc * 32 + 8 * fq;
        const float* bp = bias + (size_t)((u.pm < ML / 256) ? (u.pm >> 4) : 8) * DFF + col0;
        f32x4 bv[2][2];
#pragma unroll
        for (int bj = 0; bj < 2; ++bj)
#pragma unroll
            for (int n = 0; n < 2; ++n) bv[bj][n] = *(const f32x4*)(bp + bj * 128 + n * 4);
#pragma unroll
        for (int ai = 0; ai < 2; ++ai)
#pragma unroll
            for (int m = 0; m < 4; ++m) { const int row = row0 + ai * 128 + m * 16; bf16* rowp = O + (size_t)row * ldc + col0;
                float rstd;
                { const f32x4* sp = (const f32x4*)(ssq + (size_t)row * 16); const f32x4 a = sp[0] + sp[1] + sp[2] + sp[3]; rstd = rsqrtf(((a[0] + a[1]) + (a[2] + a[3])) * (1.f / DM) + EPS); }
#pragma unroll
                for (int bj = 0; bj < 2; ++bj) {
                    f32x4 v0 = acc[ai][bj][m][0] * rstd + bv[bj][0], v1 = acc[ai][bj][m][1] * rstd + bv[bj][1];
#pragma unroll
                    for (int e = 0; e < 4; ++e) { const float a = fmaxf(v0[e], 0.f), b = fmaxf(v1[e], 0.f); v0[e] = a * a; v1[e] = b * b; }
                    u32x4 w; w.x = cvtpk(v0[0], v0[1]); w.y = cvtpk(v0[2], v0[3]); w.z = cvtpk(v1[0], v1[1]); w.w = cvtpk(v1[2], v1[3]);
                    *(u32x4*)(rowp + bj * 128) = w; } }
    }
};
#ifndef EPIRES_FENCE
#define EPIRES_FENCE
#endif
struct EpiRes {
    static constexpr bool PERM = true, AFTER_DRAIN = false;
    const void* srcL; _Float16* dstL; const void* srcC; _Float16* dstC; int src_f32; const float* gate;
    const float* nxt_g; const float* nxt_sc; bf16* XG; float* ssq;
    __device__ __forceinline__ void operator()(const pg8::f32x4 (&acc)[2][2][4][2], const pg8::Unit& u, int wr, int wc, int fr, int fq) const {
        const bool lat = u.pm < ML / 256;
        const int bidx = lat ? (u.pm >> 4) : 8;
        const float* g = gate + (size_t)bidx * 6144;
        const size_t rbase = lat ? 0 : (size_t)ML * DM;
        const float* src32 = (const float*)(lat ? srcL : srcC) - rbase; const _Float16* src16 = (const _Float16*)(lat ? srcL : srcC) - rbase;
        _Float16* dst = (lat ? dstL : dstC) - rbase;
        const int row0 = u.pm * 256 + wr * 64 + fr, col0 = u.pn * 256 + wc * 32 + 8 * fq;
        const bool has_next = nxt_g != nullptr;
        float ss[2][4];
#pragma unroll
        for (int ai = 0; ai < 2; ++ai)
#pragma unroll
            for (int m = 0; m < 4; ++m) ss[ai][m] = 0.f;
#pragma unroll
        for (int bj = 0; bj < 2; ++bj) { const int col = col0 + bj * 128;
            const f32x4 gv0 = *(const f32x4*)(g + col), gv1 = *(const f32x4*)(g + col + 4);
            f32x4 gm0 = {0.f, 0.f, 0.f, 0.f}, gm1 = {0.f, 0.f, 0.f, 0.f};
            if (has_next) { const float* sc = nxt_sc + (size_t)bidx * 6144 + col;
                gm0 = *(const f32x4*)(nxt_g + col) * (*(const f32x4*)sc + 1.f); gm1 = *(const f32x4*)(nxt_g + col + 4) * (*(const f32x4*)(sc + 4) + 1.f); }
#pragma unroll
            for (int ai = 0; ai < 2; ++ai)
#pragma unroll
                for (int m = 0; m < 4; ++m) { const size_t off = (size_t)(row0 + ai * 128 + m * 16) * DM + col;
                    f32x4 x0, x1;
                    if (src_f32) { x0 = *(const f32x4*)(src32 + off); x1 = *(const f32x4*)(src32 + off + 4); }
                    else { const u32x4 raw = *(const u32x4*)(src16 + off); const u32x2 lo = {raw[0], raw[1]}, hi2 = {raw[2], raw[3]};
                        x0 = __builtin_convertvector(__builtin_bit_cast(h16x4, lo), f32x4); x1 = __builtin_convertvector(__builtin_bit_cast(h16x4, hi2), f32x4); }
                    const f32x4 n0 = x0 + gv0 * acc[ai][bj][m][0], n1 = x1 + gv1 * acc[ai][bj][m][1];
                    { const u32x2 lo = __builtin_bit_cast(u32x2, __builtin_convertvector(n0, h16x4)), hi2 = __builtin_bit_cast(u32x2, __builtin_convertvector(n1, h16x4));
                      *(u32x4*)(dst + off) = (u32x4){lo[0], lo[1], hi2[0], hi2[1]}; }
                    if (has_next) { ss[ai][m] += ((n0[0] * n0[0] + n0[1] * n0[1]) + (n0[2] * n0[2] + n0[3] * n0[3])) + ((n1[0] * n1[0] + n1[1] * n1[1]) + (n1[2] * n1[2] + n1[3] * n1[3]));
                        const f32x4 y0 = n0 * gm0, y1 = n1 * gm1;
                        *(u32x4*)(XG + off) = (u32x4){cvtpk(y0[0], y0[1]), cvtpk(y0[2], y0[3]), cvtpk(y1[0], y1[1]), cvtpk(y1[2], y1[3])}; } }
        }
        if (has_next) {
#pragma unroll
            for (int ai = 0; ai < 2; ++ai)
#pragma unroll
                for (int m = 0; m < 4; ++m) { float v = ss[ai][m]; v += __shfl_xor(v, 16); v += __shfl_xor(v, 32);
                    if (fq == 0) ssq[(size_t)(row0 + ai * 128 + m * 16) * 16 + u.pn * 4 + wc] = v; }
        }
    }
};

struct EpiPartial {
    static constexpr bool PERM = false, AFTER_DRAIN = false;
    float* PART;
    __device__ __forceinline__ void operator()(const pg8::f32x4 (&acc)[2][2][4][2], const pg8::Unit& u, int wr, int wc, int fr, int fq) const {
        const int row0 = u.pm * 256 + wr * 64 + fr, col0 = u.pn * 256 + wc * 32 + 4 * fq;
#pragma unroll
        for (int ai = 0; ai < 2; ++ai)
#pragma unroll
            for (int m = 0; m < 4; ++m)
#pragma unroll
                for (int bj = 0; bj < 2; ++bj)
#pragma unroll
                    for (int n = 0; n < 2; ++n) *(f32x4*)(PART + (size_t)(row0 + ai * 128 + m * 16) * DM + col0 + bj * 128 + n * 16) = acc[ai][bj][m][n];
    }
};
struct OneUnit {
    pg8::Unit u0;
    __device__ __forceinline__ bool next(int i, pg8::Unit& u) const { if (i) return false; u = u0; return true; }
    __device__ __forceinline__ void a_ready(const pg8::Unit&) const {}
    __device__ __forceinline__ void done(const pg8::Unit&) const {}
};
__device__ __forceinline__ void ctx_finalize_phase(_Float16* XC, const float* PART, const float* gate8, const float* nxt_g, const float* nxt_sc8, bf16* H, float* ssq, int lane, int wave) {
    const int gw = blockIdx.x * 8 + wave, NGW = gridDim.x * 8;
    for (int row = gw; row < MC; row += NGW) {
        h16x4* xr = (h16x4*)(XC + (size_t)row * DM) + lane;
        f32x4 v[4]; float s = 0.f;
#pragma unroll
        for (int j = 0; j < 4; ++j) {
            f32x4 a = {0.f, 0.f, 0.f, 0.f};
#pragma unroll
            for (int ks = 0; ks < 8; ++ks) a += *((const f32x4*)(PART + ((size_t)ks * MC + row) * DM) + lane + 64 * j);
            v[j] = __builtin_convertvector(xr[64 * j], f32x4) + *((const f32x4*)gate8 + lane + 64 * j) * a; xr[64 * j] = __builtin_convertvector(v[j], h16x4);
            s += (v[j][0] * v[j][0] + v[j][1] * v[j][1]) + (v[j][2] * v[j][2] + v[j][3] * v[j][3]); }
        const float tot = wave_sum(s);
        u32x2* o = (u32x2*)(H + (size_t)(ML + row) * DM) + lane;
#pragma unroll
        for (int j = 0; j < 4; ++j) { const f32x4 y = v[j] * *((const f32x4*)nxt_g + lane + 64 * j) * (*((const f32x4*)nxt_sc8 + lane + 64 * j) + 1.f);
            u32x2 w; w.x = cvtpk(y[0], y[1]); w.y = cvtpk(y[2], y[3]); o[64 * j] = w; }
        if (lane < 16) ssq[(size_t)(ML + row) * 16 + lane] = (lane == 0) ? tot : 0.f;
    }
}

__device__ __forceinline__ void transpose_item(const float* W, int K, int N, bf16* WT, LAS float* scr, int item, int lane, int perm_lim = 0) {
    const int nblk = N / 32, kb = item / nblk, nb = item % nblk, k0 = 64 * kb, n0 = 32 * nb;
#pragma unroll 8
    for (int i = 0; i < 32; ++i) { const int kk = 2 * i + (lane >> 5); scr[kk * 33 + (lane & 31)] = W[(size_t)(k0 + kk) * N + n0 + (lane & 31)]; }
    asm volatile("s_waitcnt lgkmcnt(0)" ::: "memory");
    const int c = lane & 7;
#pragma unroll
    for (int j = 0; j < 4; ++j) { const int n = (lane >> 3) + 8 * j; const LAS float* s = scr + (8 * c) * 33 + n;
        u32x4 o; o.x = cvtpk(s[0 * 33], s[1 * 33]); o.y = cvtpk(s[2 * 33], s[3 * 33]); o.z = cvtpk(s[4 * 33], s[5 * 33]); o.w = cvtpk(s[6 * 33], s[7 * 33]);
        const int nn = (n0 < perm_lim) ? rope_perm32(n) : n;
        *(u32x4*)(WT + (size_t)(n0 + nn) * K + k0 + 8 * c) = o; }
    asm volatile("s_waitcnt lgkmcnt(0)" ::: "memory");
}

__device__ __forceinline__ void gemv9_item(const float* Wc, int ldw, const LAS float* vec, LAS float* red, float* outc, int ldo, const float* addb, int tid, int lane, int wave, bool perm = false);
__device__ __forceinline__ void transposes_layer(const Params& P, int l, LAS unsigned char* lds, int gw, int NGW, int wave, int lane) {
    unsigned char* ws = P.ws;
    LAS float* scr = (LAS float*)(lds + wave * 16384);
    constexpr int I_IN = (DM / 64) * (INW / 32), I_OUT = (DM / 64) * (DM / 32), I_1 = (DM / 64) * (DFF / 32), I_2 = (DFF / 64) * (DM / 32), I_P = 2;
    constexpr int PER_L = I_IN + I_OUT + I_1 + I_2 + 4 * I_P;
    for (int it = gw; it < PER_L; it += NGW) {
        int r = it;
        if (r < I_IN) { transpose_item(P.w_in + (size_t)l * DM * INW, DM, INW, (bf16*)(ws + OFF_WIN) + (size_t)l * INW * DM, scr, r, lane, 1024); continue; } r -= I_IN;
        if (r < I_OUT) { transpose_item(P.w_out + (size_t)l * DM * DM, DM, DM, (bf16*)(ws + OFF_WOUT) + (size_t)l * DM * DM, scr, r, lane); continue; } r -= I_OUT;
        if (r < I_1) { transpose_item(P.w1 + (size_t)l * DM * DFF, DM, DFF, (bf16*)(ws + OFF_W1) + (size_t)l * DFF * DM, scr, r, lane); continue; } r -= I_1;
        if (r < I_2) { transpose_item(P.w2 + (size_t)l * DFF * DM, DFF, DM, (bf16*)(ws + OFF_W2) + (size_t)l * DM * DFF, scr, r, lane); continue; } r -= I_2;
        const int g = r / I_P; r %= I_P;
        transpose_item(P.w_pool + (size_t)(l * 4 + g) * 4096, 64, 64, (bf16*)(ws + OFF_WPT) + (size_t)(l * 4 + g) * 4096, scr, r, lane);
    }
}
__device__ __forceinline__ void prologue(const Params& P, LAS unsigned char* lds, int tid, int lane, int wave) {
    unsigned char* ws = P.ws;
    const int G = gridDim.x, gw = blockIdx.x * 8 + wave, NGW = G * 8;
    for (int l = 0; l < DEPTH; ++l) transposes_layer(P, l, lds, gw, NGW, wave, lane);
    {
        bf16* wsp = (bf16*)(ws + OFF_WSP);
        for (int i = blockIdx.x * NTHR + tid; i < DEPTH * 4 * 128 * 128 / 4; i += G * NTHR) {
            const f32x4 v = *(const f32x4*)(P.w_sp + (size_t)i * 4); u32x2 o; o.x = cvtpk(v[0], v[1]); o.y = cvtpk(v[2], v[3]); *(u32x2*)(wsp + (size_t)i * 4) = o; }
    }
    if (blockIdx.x == (unsigned)(G - 1)) {
        float* cosT = (float*)(ws + OFF_TAB); float* sinT = cosT + 1024; float* lam = cosT + 2048;
        for (int idx = tid; idx < 1024; idx += NTHR) {
            const int pos = idx >> 4, i = idx & 15;
            const float inv = __builtin_amdgcn_exp2f(-(float)i * (13.287712379549449f / 16.0f));
            const double rev0 = (double)pos * (double)inv * 0.15915494309189535; const float rev = (float)(rev0 - floor(rev0));
            cosT[idx] = __builtin_amdgcn_cosf(rev); sinT[idx] = __builtin_amdgcn_sinf(rev);
        }
        if (tid < DEPTH) {
            const int l = tid; float s1 = 0.f, s2 = 0.f;
            for (int i = 0; i < 64; ++i) { s1 += P.lq1[l * 64 + i] * P.lk1[l * 64 + i]; s2 += P.lq2[l * 64 + i] * P.lk2[l * 64 + i]; }
            const float lam_init = 0.8f - 0.6f * expf(-0.3f * (float)l);
            lam[l] = expf(s1) - expf(s2) + lam_init;
        }
    }
    __syncthreads();
    {
        LAS float* vec = (LAS float*)lds; LAS float* red = (LAS float*)(lds + 1024 * 12 * 4);
        for (int i = tid; i < 9 * 1024; i += NTHR) { const int j = i >> 10, k = i & 1023; const float v = (j < 8) ? P.c[j * 1024 + k] : P.c_ctx[k]; vec[k * 12 + j] = v / (1.f + __expf(-v)); }
        __syncthreads();
        float* mod = (float*)(ws + OFF_MOD);
        for (int it = blockIdx.x; it < DEPTH * 48; it += G) {
            const int l = it / 48, n0 = (it % 48) * 128;
            gemv9_item(P.w_ada + (size_t)l * DM * 6144 + n0, 6144, vec, red, mod + (size_t)l * 9 * 6144 + n0, 6144, P.b_ada + l * 6144 + n0, tid, lane, wave);
        }
    }
}

__device__ __forceinline__ void gemv9_item(const float* Wc  , int ldw, const LAS float* vec, LAS float* red, float* outc  , int ldo, const float* addb  , int tid, int lane, int wave, bool perm) {
    f32x2_t a[9];
#pragma unroll
    for (int j = 0; j < 9; ++j) a[j] = (f32x2_t){0.f, 0.f};
    const int k0 = wave * 128; const float* W = Wc + 2 * lane;
#pragma unroll 1
    for (int kb = 0; kb < 128; kb += 32) {
        f32x2_t w[32];
#pragma unroll
        for (int i = 0; i < 32; ++i) w[i] = *(const f32x2_t*)(W + (size_t)(k0 + kb + i) * ldw);
#pragma unroll
        for (int i = 0; i < 32; ++i) {
            if ((i & 3) == 0) asm volatile("" ::: "memory");
            const LAS f32x4* vp = (const LAS f32x4*)(vec + (k0 + kb + i) * 12); const f32x4 v0 = vp[0], v1 = vp[1], v2 = vp[2];
            a[0] += w[i] * v0[0]; a[1] += w[i] * v0[1]; a[2] += w[i] * v0[2]; a[3] += w[i] * v0[3]; a[4] += w[i] * v1[0]; a[5] += w[i] * v1[1]; a[6] += w[i] * v1[2]; a[7] += w[i] * v1[3]; a[8] += w[i] * v2[0]; }
    }
#pragma unroll
    for (int j = 0; j < 9; ++j) *(LAS f32x2_t*)(red + (wave * 9 + j) * 128 + 2 * lane) = a[j];
    __syncthreads();
    for (int idx = tid; idx < 9 * 128; idx += NTHR) { const int j = idx >> 7, ln = idx & 127; float sacc = 0.f;
#pragma unroll
        for (int w_ = 0; w_ < 8; ++w_) sacc += red[(w_ * 9 + j) * 128 + ln];
        const int lo_ = perm ? ((ln & 96) + rope_perm32(ln & 31)) : ln;
        outc[(size_t)j * ldo + lo_] = sacc + (addb ? addb[ln] : 0.f); }
    __syncthreads();
}
__device__ __forceinline__ void bias_layer(const Params& P, int l, LAS unsigned char* lds, int first, int stride, int tid, int lane, int wave) {
    unsigned char* ws = P.ws;
    const float* mod = (const float*)(ws + OFF_MOD);
    LAS float* vec = (LAS float*)lds; LAS float* red = (LAS float*)(lds + 1024 * 12 * 4);
    for (int r = first; r < 50; r += stride) {
        const bool isin = r < 18; const int cb = isin ? r : r - 18;
        const float* sh = mod + (size_t)l * 9 * 6144 + (isin ? 0 : 3) * 1024;
        for (int i = tid; i < 9 * 1024; i += NTHR) { const int j = i >> 10, k = i & 1023; vec[k * 12 + j] = sh[(size_t)j * 6144 + k]; }
        __syncthreads();
        if (isin) gemv9_item(P.w_in + (size_t)l * DM * INW + cb * 128, INW, vec, red, (float*)(ws + OFF_BIN) + (size_t)l * 9 * INW + cb * 128, INW, nullptr, tid, lane, wave, cb * 128 < 1024);
        else gemv9_item(P.w1 + (size_t)l * DM * DFF + cb * 128, DFF, vec, red, (float*)(ws + OFF_B1) + (size_t)l * 9 * DFF + cb * 128, DFF, nullptr, tid, lane, wave);
    }
}
__device__ __forceinline__ void prep_phase(const Params& P, LAS unsigned char* lds, int tid, int lane, int wave) {
    unsigned char* ws = P.ws;
    const float* mod = (const float*)(ws + OFF_MOD);
    LAS float* vec = (LAS float*)lds; LAS float* red = (LAS float*)(lds + 1024 * 12 * 4);
    for (int l = 0; l < DEPTH; ++l) bias_layer(P, l, lds, (blockIdx.x + 192 * l) % gridDim.x, gridDim.x, tid, lane, wave);
    const int gw = blockIdx.x * 8 + wave, NGW = gridDim.x * 8;
    bf16* H = (bf16*)(ws + OFF_H); float* ssq = (float*)(ws + OFF_SSQ);
    f32x4 gv[4];
#pragma unroll
    for (int j = 0; j < 4; ++j) gv[j] = *((const f32x4*)P.g_mix + lane + 64 * j);
    for (int row = gw; row < MT; row += NGW) {
        const float* xr = row < ML ? P.x + (size_t)row * DM : P.ctx + (size_t)(row - ML) * DM;
        const int bidx = row < ML ? (row >> 12) : 8;
        const float* sc = mod + (size_t)bidx * 6144 + 1024;
        f32x4 v[4]; float s = 0.f;
#pragma unroll
        for (int j = 0; j < 4; ++j) { v[j] = *((const f32x4*)xr + lane + 64 * j); s += (v[j][0] * v[j][0] + v[j][1] * v[j][1]) + (v[j][2] * v[j][2] + v[j][3] * v[j][3]); }
        const float tot = wave_sum(s);
        u32x2* o = (u32x2*)(H + (size_t)row * DM) + lane;
#pragma unroll
        for (int j = 0; j < 4; ++j) { const f32x4 scv = *((const f32x4*)sc + lane + 64 * j);
            const f32x4 y = v[j] * gv[j] * (scv + 1.f); u32x2 w; w.x = cvtpk(y[0], y[1]); w.y = cvtpk(y[2], y[3]); o[64 * j] = w; }
        if (lane < 16) ssq[(size_t)row * 16 + lane] = (lane == 0) ? tot : 0.f;
    }
}
__device__ __forceinline__ void final_norm_phase(const _Float16* xl, float* out, const float* g, int lane, int wave) {
    const int gw = blockIdx.x * 8 + wave, NGW = gridDim.x * 8;
    f32x4 gv[4];
#pragma unroll
    for (int j = 0; j < 4; ++j) gv[j] = *((const f32x4*)g + lane + 64 * j);
    for (int row = gw; row < ML; row += NGW) {
        const h16x4* xr = (const h16x4*)(xl + (size_t)row * DM) + lane; f32x4* orow = (f32x4*)(out + (size_t)row * DM) + lane;
        f32x4 v[4]; float s = 0.f;
#pragma unroll
        for (int j = 0; j < 4; ++j) { v[j] = __builtin_convertvector(xr[64 * j], f32x4); s += (v[j][0] * v[j][0] + v[j][1] * v[j][1]) + (v[j][2] * v[j][2] + v[j][3] * v[j][3]); }
        const float rstd = rsqrtf(wave_sum(s) * (1.f / DM) + EPS);
#pragma unroll
        for (int j = 0; j < 4; ++j) orow[64 * j] = v[j] * rstd * gv[j];
    }
}

constexpr int AT_KV = 0;
constexpr int AT_WS = 65536;
constexpr int AT_EX = 67584;
constexpr float THR = 8.f;

__device__ __forceinline__ void glds16(const void* gsrc, unsigned lds_dst) { unsigned keep;
    asm volatile("s_mov_b32 %0, m0\n\ts_mov_b32 m0, %2\n\ts_nop 0\n\tglobal_load_lds_dwordx4 %1, off\n\ts_mov_b32 m0, %0" : "=&s"(keep) : "v"(gsrc), "s"(lds_dst) : "memory"); }
__device__ __forceinline__ s16x4 vtr(const LAS unsigned char* p) { return __builtin_bit_cast(s16x4, __builtin_amdgcn_ds_read_tr16_b64_v4i16((LAS s16x4*)p)); }

__device__ __forceinline__ void attn_unit(const bf16* Z, bf16* MIX, int qrow0, int h, int ka, int nta, int kb, int ntb, float lam, float post, const float* gsub, LAS unsigned char* lds, int tid, int lane, int wave) {
    const int r32 = lane & 31, hi = lane >> 5, comp = wave >> 2, rg = wave & 3;
    const int NT = nta + ntb;
    const unsigned lds0 = (unsigned)(size_t)lds;
    unsigned ksrc[2], vsrc[2], kdst[2], vdst[2];
#pragma unroll
    for (int u = 0; u < 2; ++u) { const int bk = wave + 8 * u;
        { const int cmp = bk >> 3, j = bk & 7, kl = lane >> 3, c = (lane & 7) ^ kl; ksrc[u] = (unsigned)((8 * j + kl) * INW + 512 + h * 128 + cmp * 64 + c * 8); kdst[u] = (unsigned)(cmp * 8192 + j * 1024); }
        { const int db = bk >> 2, p = bk & 3, kl = lane >> 2, ch = lane & 3; vsrc[u] = (unsigned)((16 * p + kl) * INW + 1024 + h * 128 + db * 32 + ch * 8); vdst[u] = (unsigned)(32768 + db * 4096 + p * 1024); } }
#define AT_ROW(t) (((t) < nta) ? ka + 64 * (t) : kb + 64 * ((t) - nta))
#define AT_DMAK(t, buf) do { const bf16* rb_ = Z + (size_t)AT_ROW(t) * INW; _Pragma("unroll") for (int u = 0; u < 2; ++u) glds16(rb_ + ksrc[u], (unsigned)__builtin_amdgcn_readfirstlane(lds0 + (buf) * 16384 + kdst[u])); } while (0)
#define AT_DMAV(t, buf) do { const bf16* rb_ = Z + (size_t)AT_ROW(t) * INW; _Pragma("unroll") for (int u = 0; u < 2; ++u) glds16(rb_ + vsrc[u], (unsigned)__builtin_amdgcn_readfirstlane(lds0 + (buf) * 16384 + vdst[u])); } while (0)
#define AT_WAITBAR() do { asm volatile("s_waitcnt vmcnt(0)" ::: "memory"); __syncthreads(); } while (0)
    AT_DMAK(0, 0); AT_DMAK(1, 1); AT_DMAV(0, 0);
    bf16x8 qr[4];
    { const bf16* qp = Z + (size_t)(qrow0 + rg * 32 + r32) * INW + h * 128 + comp * 64 + hi * 8;
#pragma unroll
      for (int d0 = 0; d0 < 4; ++d0) qr[d0] = *(const bf16x8*)(qp + d0 * 16); }
    AT_WAITBAR();
    LAS float* wsf = (LAS float*)(lds + AT_WS) + wave * 64;
    f32x16 o[4];
#pragma unroll
    for (int d = 0; d < 4; ++d) o[d] = f32x16{};
    f32x16 negm = f32x16{};
    float mhat = 0.f, lsum = 0.f;
    const int koff = comp * 8192 + r32 * 128;
    const int voff = 32768 + ((lane >> 4) & 1) * 32 + (lane & 3) * 8 + (4 * hi + ((lane & 15) >> 2)) * 64;
    f32x16 C0, C1, P0, P1;
#define AT_ROWMAX(rm) do { float a_ = fmaxf(fmaxf(C0[0], C0[1]), C1[0]), b_ = fmaxf(fmaxf(C0[2], C0[3]), C1[1]); a_ = fmaxf(fmaxf(a_, C1[2]), C1[3]); \
        _Pragma("unroll") for (int r = 4; r < 16; r += 4) { a_ = fmaxf(fmaxf(a_, C0[r]), C0[r + 1]); b_ = fmaxf(fmaxf(b_, C0[r + 2]), C0[r + 3]); a_ = fmaxf(fmaxf(a_, C1[r]), C1[r + 1]); b_ = fmaxf(fmaxf(b_, C1[r + 2]), C1[r + 3]); } \
        rm = fmaxf(a_, b_); rm = fmaxf(rm, __shfl_xor(rm, 32)); } while (0)
    {
        const LAS unsigned char* kb_ = lds;
        C0 = negm; C1 = negm;
#pragma unroll
        for (int d0 = 0; d0 < 4; ++d0) { const int sw = (((2 * d0 + hi) ^ (r32 & 7)) << 4);
            C0 = __builtin_amdgcn_mfma_f32_32x32x16_bf16(*(const LAS bf16x8*)(kb_ + koff + sw), qr[d0], C0, 0, 0, 0);
            C1 = __builtin_amdgcn_mfma_f32_32x32x16_bf16(*(const LAS bf16x8*)(kb_ + koff + 32 * 128 + sw), qr[d0], C1, 0, 0, 0); }
        float rm; AT_ROWMAX(rm);
        mhat = rm;
#pragma unroll
        for (int r = 0; r < 16; ++r) { P0[r] = __builtin_amdgcn_exp2f(C0[r] - rm); P1[r] = __builtin_amdgcn_exp2f(C1[r] - rm); negm[r] = -mhat; }
    }
    __syncthreads();
    if (wave >= 4) __builtin_amdgcn_s_setprio(1);
    for (int t = 1; t < NT; ++t) {
        const LAS unsigned char* kb_ = lds + (t & 1) * 16384;
        const LAS unsigned char* vb_ = lds + ((t - 1) & 1) * 16384 + voff;
        if (t + 1 < NT) AT_DMAK(t + 1, (t + 1) & 1);
        AT_DMAV(t, t & 1);
        u32x4 pw[4]; float sacc = 0.f;
        C0 = negm; C1 = negm;
#pragma unroll
        for (int d0 = 0; d0 < 4; ++d0) { const int sw = (((2 * d0 + hi) ^ (r32 & 7)) << 4);
            C0 = __builtin_amdgcn_mfma_f32_32x32x16_bf16(*(const LAS bf16x8*)(kb_ + koff + sw), qr[d0], C0, 0, 0, 0);
            sacc += (P0[4 * d0] + P0[4 * d0 + 1]) + (P0[4 * d0 + 2] + P0[4 * d0 + 3]);
            pw[d0 >> 1][(d0 & 1) * 2] = cvtpk(P0[4 * d0], P0[4 * d0 + 1]); pw[d0 >> 1][(d0 & 1) * 2 + 1] = cvtpk(P0[4 * d0 + 2], P0[4 * d0 + 3]);
            C1 = __builtin_amdgcn_mfma_f32_32x32x16_bf16(*(const LAS bf16x8*)(kb_ + koff + 32 * 128 + sw), qr[d0], C1, 0, 0, 0);
            sacc += (P1[4 * d0] + P1[4 * d0 + 1]) + (P1[4 * d0 + 2] + P1[4 * d0 + 3]);
            pw[2 + (d0 >> 1)][(d0 & 1) * 2] = cvtpk(P1[4 * d0], P1[4 * d0 + 1]); pw[2 + (d0 >> 1)][(d0 & 1) * 2 + 1] = cvtpk(P1[4 * d0 + 2], P1[4 * d0 + 3]); }
        lsum += sacc;
        __builtin_amdgcn_sched_group_barrier(0x008, 2, 1);
#pragma unroll
        for (int i_ = 0; i_ < 6; ++i_) { __builtin_amdgcn_sched_group_barrier(0x400, 5, 1); __builtin_amdgcn_sched_group_barrier(0x008, 1, 1); }
        __builtin_amdgcn_sched_group_barrier(0x400, 2, 1);
        float rm; AT_ROWMAX(rm);
        bool resc = false;
        if (__any(rm > THR)) {
            const float dl = fmaxf(rm, 0.f);
            mhat += dl;
#pragma unroll
            for (int r = 0; r < 16; ++r) { C0[r] -= dl; C1[r] -= dl; negm[r] = -mhat; }
            const float f = __builtin_amdgcn_exp2f(-dl);
            lsum *= f;
            if (hi == 0) wsf[r32] = f;
            resc = true;
        }
#pragma unroll
        for (int d0 = 0; d0 < 4; ++d0)
#pragma unroll
            for (int ks = 0; ks < 4; ++ks) {
                const s16x4 lo = vtr(vb_ + d0 * 4096 + ks * 1024), hh = vtr(vb_ + d0 * 4096 + ks * 1024 + 512);
                const bf16x8 vf = (bf16x8){lo[0], lo[1], lo[2], lo[3], hh[0], hh[1], hh[2], hh[3]};
                o[d0] = __builtin_amdgcn_mfma_f32_32x32x16_bf16(__builtin_bit_cast(bf16x8, pw[ks]), vf, o[d0], 0, 0, 0);
                const int e = (d0 * 4 + ks);
                if (e < 8) { P0[2 * e] = __builtin_amdgcn_exp2f(C0[2 * e]); P0[2 * e + 1] = __builtin_amdgcn_exp2f(C0[2 * e + 1]); }
                else { P1[2 * e - 16] = __builtin_amdgcn_exp2f(C1[2 * e - 16]); P1[2 * e - 15] = __builtin_amdgcn_exp2f(C1[2 * e - 15]); }
            }
        if (resc) {
#pragma unroll
            for (int r = 0; r < 16; ++r) { const float fr_ = wsf[crow(r, hi)];
#pragma unroll
                for (int d = 0; d < 4; ++d) o[d][r] *= fr_; }
        }
        AT_WAITBAR();
    }
    __builtin_amdgcn_s_setprio(0);
    {
        const LAS unsigned char* vb_ = lds + ((NT - 1) & 1) * 16384 + voff;
        float sacc = 0.f;
#pragma unroll
        for (int r = 0; r < 16; ++r) sacc += P0[r] + P1[r];
        lsum += sacc;
        u32x4 pw[4];
        pw[0] = (u32x4){cvtpk(P0[0], P0[1]), cvtpk(P0[2], P0[3]), cvtpk(P0[4], P0[5]), cvtpk(P0[6], P0[7])};
        pw[1] = (u32x4){cvtpk(P0[8], P0[9]), cvtpk(P0[10], P0[11]), cvtpk(P0[12], P0[13]), cvtpk(P0[14], P0[15])};
        pw[2] = (u32x4){cvtpk(P1[0], P1[1]), cvtpk(P1[2], P1[3]), cvtpk(P1[4], P1[5]), cvtpk(P1[6], P1[7])};
        pw[3] = (u32x4){cvtpk(P1[8], P1[9]), cvtpk(P1[10], P1[11]), cvtpk(P1[12], P1[13]), cvtpk(P1[14], P1[15])};
#pragma unroll
        for (int d0 = 0; d0 < 4; ++d0)
#pragma unroll
            for (int ks = 0; ks < 4; ++ks) {
                const s16x4 lo = vtr(vb_ + d0 * 4096 + ks * 1024), hh = vtr(vb_ + d0 * 4096 + ks * 1024 + 512);
                const bf16x8 vf = (bf16x8){lo[0], lo[1], lo[2], lo[3], hh[0], hh[1], hh[2], hh[3]};
                o[d0] = __builtin_amdgcn_mfma_f32_32x32x16_bf16(__builtin_bit_cast(bf16x8, pw[ks]), vf, o[d0], 0, 0, 0);
            }
    }
#undef AT_ROW
#undef AT_DMAK
#undef AT_DMAV
#undef AT_WAITBAR
#undef AT_ROWMAX
    lsum += __shfl_xor(lsum, 32);
    const float inv = (comp == 0 ? 1.f : lam) / lsum;
    if (hi == 0) wsf[r32] = inv;
    asm volatile("s_waitcnt lgkmcnt(0)" ::: "memory");
    float rl[16];
#pragma unroll
    for (int r = 0; r < 16; ++r) rl[r] = wsf[crow(r, hi)];
    LAS float* ex = (LAS float*)(lds + AT_EX) + rg * 4096 + lane;
    if (comp == 1) {
#pragma unroll
        for (int d = 0; d < 4; ++d)
#pragma unroll
            for (int r = 0; r < 16; ++r) ex[(d * 16 + r) * 64] = o[d][r] * rl[r];
    }
    __syncthreads();
    if (comp == 0) {
        float ss[16];
#pragma unroll
        for (int r = 0; r < 16; ++r) { float s = 0.f;
#pragma unroll
            for (int d = 0; d < 4; ++d) { const float a = o[d][r] * rl[r] - ex[(d * 16 + r) * 64]; o[d][r] = a; s += a * a; }
            ss[r] = s; }
#pragma unroll
        for (int r = 0; r < 16; ++r) {
#pragma unroll
            for (int off = 1; off < 32; off <<= 1) ss[r] += __shfl_xor(ss[r], off);
            ss[r] = rsqrtf(ss[r] * (1.f / 128.f) + EPS) * post; }
        LAS bf16* stg = (LAS bf16*)((LAS float*)(lds + AT_EX) + rg * 4096);
#pragma unroll
        for (int d = 0; d < 4; ++d) { const float gs = gsub[d * 32 + r32];
#pragma unroll
            for (int r = 0; r < 16; ++r) stg[crow(r, hi) * 136 + d * 32 + r32] = f2bf(o[d][r] * ss[r] * gs); }
#pragma unroll
        for (int i = 0; i < 8; ++i) { const int idx = lane + 64 * i, row = idx >> 4, ch = idx & 15;
            const u32x4 v = *(const LAS u32x4*)(stg + row * 136 + ch * 8);
            *(u32x4*)(MIX + (size_t)(qrow0 + rg * 32 + row) * DM + h * 128 + ch * 8) = v; }
    }
    __syncthreads();
}

__device__ __forceinline__ void gate_item(const bf16* Z, bf16* MIX, int tok0, int g, const bf16* Wsp_lg, const float* bsp_lg, const float* gv_l, LAS unsigned char* lds, int tid, int lane, int wave) {
    LAS bf16* vnT = (LAS bf16*)lds;
    {
        const int q = tid >> 2, cq = tid & 3;
        const bf16* src = Z + (size_t)(tok0 + q) * INW + 1792 + g * 64 + cq * 16;
        const u32x4 a = *(const u32x4*)src, b = *(const u32x4*)(src + 8);
        float x[16];
#pragma unroll
        for (int i = 0; i < 4; ++i) { x[2 * i] = bflo(a[i]); x[2 * i + 1] = bfhi(a[i]); x[8 + 2 * i] = bflo(b[i]); x[8 + 2 * i + 1] = bfhi(b[i]); }
        float ss = 0.f;
#pragma unroll
        for (int i = 0; i < 16; ++i) ss += x[i] * x[i];
        ss += __shfl_xor(ss, 1); ss += __shfl_xor(ss, 2);
        const float rstd = rsqrtf(ss * (1.f / 64.f) + EPS);
#pragma unroll
        for (int i = 0; i < 16; ++i) vnT[(cq * 16 + i) * 136 + q] = f2bf(x[i] * rstd * gv_l[g * 64 + cq * 16 + i]);
    }
    __syncthreads();
    const int r32 = lane & 31, hi = lane >> 5, pb = wave & 3, cb = wave >> 2;
    f32x16 acc = f32x16{};
#pragma unroll
    for (int s = 0; s < 8; ++s) {
        const bf16x8 A = *(const bf16x8*)(Wsp_lg + (size_t)(pb * 32 + r32) * 128 + 16 * s + 8 * hi);
        const bf16x8 B = *(const LAS bf16x8*)(vnT + (cb * 32 + r32) * 136 + 16 * s + 8 * hi);
        acc = __builtin_amdgcn_mfma_f32_32x32x16_bf16(A, B, acc, 0, 0, 0);
    }
    const int c = cb * 32 + r32;
#pragma unroll
    for (int r = 0; r < 16; ++r) { const int p = pb * 32 + crow(r, hi); const size_t tok = (size_t)(tok0 + p);
        const float u = bf2f(Z[tok * INW + 1536 + g * 64 + c]);
        MIX[tok * DM + 512 + g * 64 + c] = f2bf((acc[r] + bsp_lg[p]) * u); }
    __syncthreads();
}

__device__ __forceinline__ void pool_item(const bf16* Z, bf16* MIX, int tok0, int g, const bf16* WpT_lg, const float* sp_l, LAS unsigned char* lds, int tid, int lane, int wave) {
    LAS bf16* pt = (LAS bf16*)lds;
    LAS bf16* dT = (LAS bf16*)(lds + 144 * 72 * 2);
    const int TS = tok0 < ML ? SEQ : CTXL, pos0 = tok0 & (TS - 1);
    for (int idx = tid; idx < 144 * 8; idx += NTHR) { const int row = idx >> 3, ch = idx & 7, pos = pos0 - 8 + row;
        u32x4 v = {0u, 0u, 0u, 0u};
        if (pos >= 0 && pos < TS) v = *(const u32x4*)(Z + (size_t)(tok0 - 8 + row) * INW + 2048 + g * 64 + ch * 8);
        *(LAS u32x4*)(pt + row * 72 + ch * 8) = v; }
    __syncthreads();
    {
        const int t = tid >> 2, cq = tid & 3, w = 2 << g, half = w >> 1, pos = pos0 + t;
        const int lo = max(pos - half, 0), hi_ = min(pos + half, TS);
        const float rc = 1.f / (float)(hi_ - lo);
        float sum[16];
#pragma unroll
        for (int i = 0; i < 16; ++i) sum[i] = 0.f;
        for (int k = 0; k < w; ++k) { const LAS bf16* rp = pt + (t + 8 - half + k) * 72 + cq * 16;
            const u32x4 a = *(const LAS u32x4*)rp, b = *(const LAS u32x4*)(rp + 8);
#pragma unroll
            for (int i = 0; i < 4; ++i) { sum[2 * i] += bflo(a[i]); sum[2 * i + 1] += bfhi(a[i]); sum[8 + 2 * i] += bflo(b[i]); sum[8 + 2 * i + 1] += bfhi(b[i]); } }
        const LAS bf16* xp = pt + (t + 8) * 72 + cq * 16;
        const u32x4 a = *(const LAS u32x4*)xp, b = *(const LAS u32x4*)(xp + 8);
        float x[16];
#pragma unroll
        for (int i = 0; i < 4; ++i) { x[2 * i] = bflo(a[i]); x[2 * i + 1] = bfhi(a[i]); x[8 + 2 * i] = bflo(b[i]); x[8 + 2 * i + 1] = bfhi(b[i]); }
        u32x4 o0, o1;
#pragma unroll
        for (int i = 0; i < 4; ++i) { o0[i] = cvtpk(sum[2 * i] * rc - x[2 * i], sum[2 * i + 1] * rc - x[2 * i + 1]); o1[i] = cvtpk(sum[8 + 2 * i] * rc - x[8 + 2 * i], sum[8 + 2 * i + 1] * rc - x[8 + 2 * i + 1]); }
        *(LAS u32x4*)(dT + t * 72 + cq * 16) = o0; *(LAS u32x4*)(dT + t * 72 + cq * 16 + 8) = o1;
    }
    __syncthreads();
    const int r32 = lane & 31, hi = lane >> 5, tb = wave & 3, eb = wave >> 2;
    f32x16 acc = f32x16{};
#pragma unroll
    for (int s = 0; s < 4; ++s) {
        const bf16x8 A = *(const LAS bf16x8*)(dT + (tb * 32 + r32) * 72 + 16 * s + 8 * hi);
        const bf16x8 B = *(const bf16x8*)(WpT_lg + (size_t)(eb * 32 + r32) * 64 + 16 * s + 8 * hi);
        acc = __builtin_amdgcn_mfma_f32_32x32x16_bf16(A, B, acc, 0, 0, 0);
    }
    const int e = eb * 32 + r32; const float sp = sp_l[g * 64 + e];
#pragma unroll
    for (int r = 0; r < 16; ++r) { const size_t tok = (size_t)(tok0 + tb * 32 + crow(r, hi)); MIX[tok * DM + 768 + g * 64 + e] = f2bf(acc[r] * sp); }
    __syncthreads();
}

__device__ __forceinline__ void small_item(const bf16* Z, bf16* MIX, int tok0, int g, const bf16* Wsp_lg, const float* bsp_lg, const float* gv_l, const bf16* WpT_lg, const float* sp_l, LAS unsigned char* lds, int tid, int lane, int wave) {
    LAS bf16* vnT = (LAS bf16*)lds;
    LAS bf16* pt = (LAS bf16*)(lds + 17408);
    LAS bf16* dT = (LAS bf16*)(lds + 38144);
    LAS bf16* uT = (LAS bf16*)(lds + 56576);
    LAS bf16* og = (LAS bf16*)(lds + 75008);
    LAS bf16* op = (LAS bf16*)(lds + 93440);
    const int TS = tok0 < ML ? SEQ : CTXL, pos0 = tok0 & (TS - 1);
    const int r32 = lane & 31, hi = lane >> 5, rb = wave & 3, cb = wave >> 2;
    const int q = tid >> 2, cq = tid & 3;
    const bf16* zrow = Z + (size_t)(tok0 + q) * INW + g * 64 + cq * 16;
    const u32x4 ga = *(const u32x4*)(zrow + 1792), gb = *(const u32x4*)(zrow + 1792 + 8);
    const u32x4 ua = *(const u32x4*)(zrow + 1536), ub = *(const u32x4*)(zrow + 1536 + 8);
    u32x4 pv[3]; int prow[3];
#pragma unroll
    for (int i = 0; i < 3; ++i) { const int idx = tid + NTHR * i; prow[i] = idx >> 3; const int ch = idx & 7, pos = pos0 - 8 + prow[i];
        pv[i] = (u32x4){0u, 0u, 0u, 0u};
        if (idx < 144 * 8 && pos >= 0 && pos < TS) pv[i] = *(const u32x4*)(Z + (size_t)(tok0 - 8 + prow[i]) * INW + 2048 + g * 64 + ch * 8); }
    bf16x8 Ag[8];
#pragma unroll
    for (int s_ = 0; s_ < 8; ++s_) Ag[s_] = *(const bf16x8*)(Wsp_lg + (size_t)(rb * 32 + r32) * 128 + 16 * s_ + 8 * hi);
    {
        float x[16];
#pragma unroll
        for (int i = 0; i < 4; ++i) { x[2 * i] = bflo(ga[i]); x[2 * i + 1] = bfhi(ga[i]); x[8 + 2 * i] = bflo(gb[i]); x[8 + 2 * i + 1] = bfhi(gb[i]); }
        float ss = 0.f;
#pragma unroll
        for (int i = 0; i < 16; ++i) ss += x[i] * x[i];
        ss += __shfl_xor(ss, 1); ss += __shfl_xor(ss, 2);
        const float rstd = rsqrtf(ss * (1.f / 64.f) + EPS);
#pragma unroll
        for (int i = 0; i < 16; ++i) vnT[(cq * 16 + i) * 136 + q] = f2bf(x[i] * rstd * gv_l[g * 64 + cq * 16 + i]);
        *(LAS u32x4*)(uT + q * 72 + cq * 16) = ua; *(LAS u32x4*)(uT + q * 72 + cq * 16 + 8) = ub;
#pragma unroll
        for (int i = 0; i < 3; ++i) { const int idx = tid + NTHR * i; if (idx < 144 * 8) *(LAS u32x4*)(pt + prow[i] * 72 + (idx & 7) * 8) = pv[i]; }
    }
    __syncthreads();
    {
        const int t = q, w = 2 << g, half = w >> 1, pos = pos0 + t;
        const int lo = max(pos - half, 0), hi_ = min(pos + half, TS);
        const float rc = 1.f / (float)(hi_ - lo);
        float sum[16];
#pragma unroll
        for (int i = 0; i < 16; ++i) sum[i] = 0.f;
        for (int k = 0; k < w; ++k) { const LAS bf16* rp = pt + (t + 8 - half + k) * 72 + cq * 16;
            const u32x4 a = *(const LAS u32x4*)rp, b = *(const LAS u32x4*)(rp + 8);
#pragma unroll
            for (int i = 0; i < 4; ++i) { sum[2 * i] += bflo(a[i]); sum[2 * i + 1] += bfhi(a[i]); sum[8 + 2 * i] += bflo(b[i]); sum[8 + 2 * i + 1] += bfhi(b[i]); } }
        const LAS bf16* xp = pt + (t + 8) * 72 + cq * 16;
        const u32x4 a = *(const LAS u32x4*)xp, b = *(const LAS u32x4*)(xp + 8);
        float x[16];
#pragma unroll
        for (int i = 0; i < 4; ++i) { x[2 * i] = bflo(a[i]); x[2 * i + 1] = bfhi(a[i]); x[8 + 2 * i] = bflo(b[i]); x[8 + 2 * i + 1] = bfhi(b[i]); }
        u32x4 o0, o1;
#pragma unroll
        for (int i = 0; i < 4; ++i) { o0[i] = cvtpk(sum[2 * i] * rc - x[2 * i], sum[2 * i + 1] * rc - x[2 * i + 1]); o1[i] = cvtpk(sum[8 + 2 * i] * rc - x[8 + 2 * i], sum[8 + 2 * i + 1] * rc - x[8 + 2 * i + 1]); }
        *(LAS u32x4*)(dT + t * 72 + cq * 16) = o0; *(LAS u32x4*)(dT + t * 72 + cq * 16 + 8) = o1;
    }
    {
        f32x16 acc = f32x16{};
#pragma unroll
        for (int s_ = 0; s_ < 8; ++s_) { const bf16x8 B = *(const LAS bf16x8*)(vnT + (cb * 32 + r32) * 136 + 16 * s_ + 8 * hi); acc = __builtin_amdgcn_mfma_f32_32x32x16_bf16(Ag[s_], B, acc, 0, 0, 0); }
        const int c = cb * 32 + r32;
#pragma unroll
        for (int r = 0; r < 16; ++r) { const int p = rb * 32 + crow(r, hi);
            og[p * 72 + c] = f2bf((acc[r] + bsp_lg[p]) * bf2f(uT[p * 72 + c])); }
    }
    __syncthreads();
    {
        f32x16 acc = f32x16{};
#pragma unroll
        for (int s_ = 0; s_ < 4; ++s_) {
            const bf16x8 A = *(const LAS bf16x8*)(dT + (rb * 32 + r32) * 72 + 16 * s_ + 8 * hi);
            const bf16x8 B = *(const bf16x8*)(WpT_lg + (size_t)(cb * 32 + r32) * 64 + 16 * s_ + 8 * hi);
            acc = __builtin_amdgcn_mfma_f32_32x32x16_bf16(A, B, acc, 0, 0, 0); }
        const int e = cb * 32 + r32; const float sp = sp_l[g * 64 + e];
#pragma unroll
        for (int r = 0; r < 16; ++r) op[(rb * 32 + crow(r, hi)) * 72 + e] = f2bf(acc[r] * sp);
    }
    __syncthreads();
    {
        bf16* mrow = MIX + (size_t)(tok0 + q) * DM + g * 64 + cq * 16;
        *(u32x4*)(mrow + 512) = *(const LAS u32x4*)(og + q * 72 + cq * 16); *(u32x4*)(mrow + 512 + 8) = *(const LAS u32x4*)(og + q * 72 + cq * 16 + 8);
        *(u32x4*)(mrow + 768) = *(const LAS u32x4*)(op + q * 72 + cq * 16); *(u32x4*)(mrow + 768 + 8) = *(const LAS u32x4*)(op + q * 72 + cq * 16 + 8);
    }
}

#define XB_TMO      128
#define XB_XCNT(j)  (256  + 64 * (j))
#define XB_XSUB(j)  (1280 + 64 * (j))
#define XB_XGEN(j)  (2304 + 64 * (j))
#define XB_TOP      3328
#define XB_TOPGEN   3392
#define XCD_BAR_WORDS 3456
#define XB_SPIN_CAP (1u << 18)

__device__ __forceinline__ unsigned xb_ld(unsigned* p)              { return __hip_atomic_load(p, __ATOMIC_RELAXED, __HIP_MEMORY_SCOPE_AGENT); }
__device__ __forceinline__ unsigned xb_add(unsigned* p, unsigned v) { return __hip_atomic_fetch_add(p, v, __ATOMIC_RELAXED, __HIP_MEMORY_SCOPE_AGENT); }
__device__ __forceinline__ unsigned xb_xcc_id() { return (unsigned)__builtin_amdgcn_s_getreg((3 << 11) | 20) & 0xFu; }
#define XB_SPIN(cond, bar) do { unsigned _sp = 0; while (cond) { __builtin_amdgcn_s_sleep(1); \
    if ((++_sp & 255u) == 0u) { if (xb_ld(&(bar)[XB_TMO])) break; if (_sp > XB_SPIN_CAP) { atomicAdd(&(bar)[XB_TMO], 1u); break; } } } } while (0)

struct XcdBarrier {
    unsigned* bar; unsigned x;
    volatile LAS unsigned* st;
};

__device__ __forceinline__ XcdBarrier xcd_barrier_post(unsigned* bar, volatile LAS unsigned* st) {
    XcdBarrier b; b.bar = bar; b.x = xb_xcc_id(); b.st = st;
    if (threadIdx.x == 0) (void)xb_add(&bar[XB_XCNT(b.x)], 1u);
    return b;
}
__device__ __forceinline__ void xcd_barrier_complete(unsigned* bar, unsigned x, unsigned& nloc, unsigned& nx) {
    const unsigned G = gridDim.x * gridDim.y * gridDim.z;
    unsigned sum, cnt, mine, sp = 0u;
    for (;;) {
        sum = 0u; cnt = 0u; mine = 0u;
#pragma unroll
        for (unsigned j = 0; j < 16; ++j) { const unsigned c = xb_ld(&bar[XB_XCNT(j)]); sum += c; cnt += (c > 0u) ? 1u : 0u; mine = (j == x) ? c : mine; }
        if (sum == G) break;
        __builtin_amdgcn_s_sleep(1);
        if ((++sp & 255u) == 0u) { if (xb_ld(&bar[XB_TMO])) break; if (sp > XB_SPIN_CAP) { atomicAdd(&bar[XB_TMO], 1u); break; } }
    }
    nloc = mine > 0u ? mine : 1u; nx = cnt > 0u ? cnt : 1u;
}

__device__ __forceinline__ void xcd_barrier(const XcdBarrier& b) {
    asm volatile("s_waitcnt vmcnt(0)" ::: "memory");
    __syncthreads();
    if (threadIdx.x == 0) {
        unsigned* bar = b.bar;
        __builtin_amdgcn_s_waitcnt(0);
        unsigned nloc = b.st[0], nx = b.st[1];
        if (nloc == 0u) { xcd_barrier_complete(bar, b.x, nloc, nx); b.st[0] = nloc; b.st[1] = nx; }
        const unsigned old = xb_add(&bar[XB_XSUB(b.x)], 1u);
        const unsigned gen = old / nloc;
        if (old + 1u == (gen + 1u) * nloc) {
            __builtin_amdgcn_fence(__ATOMIC_RELEASE, "agent");
            asm volatile("s_waitcnt vmcnt(0)" ::: "memory");
            const unsigned og = xb_add(&bar[XB_TOP], 1u);
            const unsigned tg = og / nx;
            if (og + 1u == (tg + 1u) * nx) xb_add(&bar[XB_TOPGEN], 1u);
            else XB_SPIN(xb_ld(&bar[XB_TOPGEN]) == tg, bar);
            __builtin_amdgcn_fence(__ATOMIC_ACQUIRE, "agent");
            xb_add(&bar[XB_XGEN(b.x)], 1u);
            asm volatile("s_waitcnt vmcnt(0)" ::: "memory");
        } else {
            XB_SPIN(xb_ld(&bar[XB_XGEN(b.x)]) == gen, bar);
            __builtin_amdgcn_fence(__ATOMIC_ACQUIRE, "agent");
            asm volatile("s_waitcnt vmcnt(0)" ::: "memory");
        }
    }
    __syncthreads();
}

__global__ void __launch_bounds__(NTHR, 2) fwd_megakernel(Params P) {
    extern __shared__ __attribute__((aligned(16))) unsigned char lds_raw[];
    LAS unsigned char* lds = (LAS unsigned char*)lds_raw;
    cg::grid_group grid = cg::this_grid();
    const int G = gridDim.x, bid = blockIdx.x;
#define TLW const int tid = opaque_tid(), lane = tid & 63, wave = __builtin_amdgcn_readfirstlane(tid >> 6); (void)tid; (void)lane; (void)wave
    unsigned char* ws = P.ws;
    float* mod = (float*)(ws + OFF_MOD);
    const float* cosT = (const float*)(ws + OFF_TAB); const float* sinT = cosT + 1024; const float* lamv = cosT + 2048;
    bf16* H = (bf16*)(ws + OFF_H); bf16* Z = (bf16*)(ws + OFF_Z); bf16* MIX = (bf16*)(ws + OFF_MIX); bf16* HID = (bf16*)(ws + OFF_HID);
    _Float16* XC = (_Float16*)(ws + OFF_XC); _Float16* XL = (_Float16*)(ws + OFF_XL);

    {   TLW;
        static_assert(XCD_BAR_WORDS == 3456, "context hand-off counters sit at word 3456 + 128");
        if (bid == 0) for (int i = tid; i < XCD_BAR_WORDS + 128 + 2048; i += NTHR) ((unsigned*)(ws + OFF_BAR))[i] = 0u;
        if (tid < 16) ((LAS unsigned*)(lds + LDS_BYTES - 64))[tid] = 0u;
        __syncthreads();
    }
#ifndef NO_PRO
    { TLW; prologue(P, lds, tid, lane, wave); }
#endif
    grid.sync();
    const XcdBarrier xbar = xcd_barrier_post((unsigned*)(ws + OFF_BAR), (volatile LAS unsigned*)(lds + LDS_BYTES - 64));
#define GRID_BAR() do { XcdBarrier xb_ = xbar; asm volatile("" : "+s"(xb_.bar)); xcd_barrier(xb_); } while (0)
    float* SSQ = (float*)(ws + OFF_SSQ);
    { TLW; prep_phase(P, lds, tid, lane, wave); }
    GRID_BAR();

    for (int l = 0; l < DEPTH; ++l) {
        const bool last = (l == DEPTH - 1);
        const void* xl_src = (l == 0) ? (const void*)P.x : (const void*)XL;
        const void* xc_src = (l == 0) ? (const void*)P.ctx : (const void*)XC;
        const float* mod_l = mod + (size_t)l * 9 * 6144;
        {
            pg8::Gemm g{H, (const bf16*)(ws + OFF_WIN) + (size_t)l * INW * DM, MT, INW, DM, DM}; pg8::StaticOrder S; S.init(MT, INW, G, bid);
            EpiInProj E{Z, cosT, sinT, SSQ, (const float*)(ws + OFF_BIN) + (size_t)l * 9 * INW};
#ifndef NO_G1
            pg8::gemm_phase<EpiInProj, pg8::StaticOrder, true, true>(lds, g, S, E);
#endif
        }
        GRID_BAR();
        {
            TLW;
            const float lam = lamv[l];
            const float lam_init = 0.8f - 0.6f * expf(-0.3f * (float)l);
            const float post = 1.f - lam_init;
            const float* gsub = P.g_sub + l * 128;
            const int n_lat = NB * 4 * (SEQ / 128);
            const int n_ctx = last ? 0 : NB * 4 * (CTXL / 128);
#ifndef NO_ATTN
            const bool fuse_ctx = (!last && G == 256);
            unsigned* cntb = (unsigned*)(ws + OFF_BAR) + 3456 + 128 + 64 * (l * 8);
#define CTX_SIGNAL(b_) do { asm volatile("s_waitcnt vmcnt(0)" ::: "memory"); __syncthreads(); \
                if (tid == 0) { __builtin_amdgcn_fence(__ATOMIC_RELEASE, "agent"); asm volatile("s_waitcnt vmcnt(0)" ::: "memory"); \
                    __hip_atomic_fetch_add(cntb + 64 * (b_), 1u, __ATOMIC_RELAXED, __HIP_MEMORY_SCOPE_AGENT); } } while (0)
            const int vcu = (G % 8 == 0) ? (bid % 8) * (G / 8) + bid / 8 : bid;
            const bf16* wsp_l = (const bf16*)(ws + OFF_WSP) + (size_t)l * 4 * 16384; const bf16* wpt_l = (const bf16*)(ws + OFF_WPT) + (size_t)l * 4 * 4096;
#define SMALL_ITEM(it_) do { const int tb_ = (it_) >> 2, g_ = (it_) & 3; \
                small_item(Z, MIX, tb_ * 128, g_, wsp_l + (size_t)g_ * 16384, P.b_sp + (l * 4 + g_) * 128, P.g_v + l * 256, wpt_l + (size_t)g_ * 4096, P.s_pool + l * 256, lds, tid, lane, wave); } while (0)
            if (fuse_ctx) {
                if (vcu < 64) { const int v = vcu, b = v >> 3, h = (v >> 1) & 3, qb = v & 1;
                    attn_unit(Z, MIX, ML + b * CTXL + qb * 128, h, ML + b * CTXL, CTXL / 64, 0, 0, lam, post, gsub, lds, tid, lane, wave); CTX_SIGNAL(b); }
                if (bid >= 128 && bid < 192) { const int it = 1024 + (bid - 128); SMALL_ITEM(it); CTX_SIGNAL(((it >> 2) - ML / 128) >> 1); }
                for (int u = vcu; u < n_lat; u += G) { const int b = u >> 7, h = (u >> 5) & 3, qb = u & 31;
                    attn_unit(Z, MIX, b * SEQ + qb * 128, h, ML + b * CTXL, CTXL / 64, b * SEQ, SEQ / 64, lam, post, gsub, lds, tid, lane, wave); }
                if (bid < 224) for (int it = bid; it < 1024; it += 224) SMALL_ITEM(it);
            } else {
                for (int u = vcu; u < n_lat + n_ctx; u += G) {
                    if (u < n_lat) { const int b = u >> 7, h = (u >> 5) & 3, qb = u & 31;
                        attn_unit(Z, MIX, b * SEQ + qb * 128, h, ML + b * CTXL, CTXL / 64, b * SEQ, SEQ / 64, lam, post, gsub, lds, tid, lane, wave);
                    } else { const int v = u - n_lat, b = v >> 3, h = (v >> 1) & 3, qb = v & 1;
                        attn_unit(Z, MIX, ML + b * CTXL + qb * 128, h, ML + b * CTXL, CTXL / 64, 0, 0, lam, post, gsub, lds, tid, lane, wave); }
                }
                const int nblk = (last ? ML : MT) / 128;
                for (int it = bid; it < nblk * 4; it += G) SMALL_ITEM(it);
            }
#undef SMALL_ITEM
#endif
            if (fuse_ctx && bid >= 224) {
                const int ci = bid - 224, b = ci >> 2, pn = ci & 3;
                if (tid == 0) { unsigned sp_ = 0;
                    while (__hip_atomic_load(cntb + 64 * b, __ATOMIC_RELAXED, __HIP_MEMORY_SCOPE_AGENT) < 16u) { __builtin_amdgcn_s_sleep(4); if (++sp_ > (1u << 22)) break; }
                    __builtin_amdgcn_fence(__ATOMIC_ACQUIRE, "agent"); asm volatile("s_waitcnt vmcnt(0)" ::: "memory"); }
                __syncthreads();
                pg8::Gemm g{MIX, (const bf16*)(ws + OFF_WOUT) + (size_t)l * DM * DM, MT, DM, DM, DM};
                OneUnit S{{ML / 256 + b, pn}};
                EpiRes E{xl_src, XL, xc_src, XC, (l == 0) ? 1 : 0, mod_l + 2 * 1024, P.g_mlp + l * DM, mod_l + 4 * 1024, H, SSQ};
                pg8::gemm_phase<EpiRes, OneUnit, false, true>(lds, g, S, E);
            }
#undef CTX_SIGNAL
        }
        GRID_BAR();
        const int Mrows = last ? ML : MT;
        {
            const int Mo = (last || G == 256) ? ML : MT;
            pg8::Gemm g{MIX, (const bf16*)(ws + OFF_WOUT) + (size_t)l * DM * DM, Mo, DM, DM, DM}; pg8::StaticOrder S; S.init(Mo, DM, G, bid);
            EpiRes E{xl_src, XL, xc_src, XC, (l == 0) ? 1 : 0, mod_l + 2 * 1024, P.g_mlp + l * DM, mod_l + 4 * 1024, H, SSQ};
#ifndef NO_G2
            pg8::gemm_phase<EpiRes, pg8::StaticOrder, true, true>(lds, g, S, E);
#endif
        }
        GRID_BAR();
        {
            pg8::Gemm g{H, (const bf16*)(ws + OFF_W1) + (size_t)l * DFF * DM, Mrows, DFF, DM, DM}; pg8::StaticOrder S; S.init(Mrows, DFF, G, bid);
            EpiSqRelu E{HID, DFF, SSQ, (const float*)(ws + OFF_B1) + (size_t)l * 9 * DFF};
#ifndef NO_G3
            pg8::gemm_phase<EpiSqRelu, pg8::StaticOrder, true, true>(lds, g, S, E);
#endif
        }
        GRID_BAR();
        {
            pg8::Gemm g{HID, (const bf16*)(ws + OFF_W2) + (size_t)l * DM * DFF, ML, DM, DFF, DFF}; pg8::StaticOrder S; S.init(ML, DM, G, bid);
            EpiRes E{XL, XL, XC, XC, 0, mod_l + 5 * 1024, last ? (const float*)nullptr : P.g_mix + (l + 1) * DM, mod_l + 9 * 6144 + 1 * 1024, H, SSQ};
#ifndef NO_G4
            pg8::gemm_phase<EpiRes, pg8::StaticOrder, true, true>(lds, g, S, E);
#endif
        }
        if (!last) {
            for (int su = bid; su < 256; su += G) {
                const int tile = su >> 3, ks = su & 7;
                pg8::Gemm g{HID + (size_t)ML * DFF + ks * 512, (const bf16*)(ws + OFF_W2) + (size_t)l * DM * DFF + ks * 512, MC, DM, 512, DFF};
                OneUnit S{{tile >> 2, tile & 3}};
                EpiPartial E{P.out + (size_t)ks * MC * DM};
                pg8::gemm_phase<EpiPartial, OneUnit, false, true>(lds, g, S, E);
            }
            GRID_BAR();
            { TLW; ctx_finalize_phase(XC, (const float*)P.out, mod_l + 8 * 6144 + 5 * 1024, P.g_mix + (l + 1) * DM, mod_l + 9 * 6144 + 8 * 6144 + 1 * 1024, H, SSQ, lane, wave); }
        }
        GRID_BAR();
    }
    { TLW; final_norm_phase(XL, P.out, P.g_final, lane, wave); }
}

extern "C" void kernel_launch(void* const* d_in, const int* in_sizes, int n_in, void* d_out, int out_size, void* d_ws, size_t ws_size, hipStream_t stream) {
    static int grid_blocks = 0;
    if (grid_blocks == 0) {
        if (n_in != 23 || ws_size < WS_NEED) { fprintf(stderr, "kernel_launch: unexpected n_in %d or ws_size %zu (need %zu)\n", n_in, ws_size, (size_t)WS_NEED); grid_blocks = -1; return; }
        int dev = 0, cus = 0, per_cu = 0;
        hipGetDevice(&dev);
        hipDeviceGetAttribute(&cus, hipDeviceAttributeMultiprocessorCount, dev);
        if (hipFuncSetAttribute((const void*)fwd_megakernel, hipFuncAttributeMaxDynamicSharedMemorySize, LDS_BYTES) != hipSuccess) { fprintf(stderr, "kernel_launch: hipFuncSetAttribute failed\n"); grid_blocks = -1; return; }
        hipOccupancyMaxActiveBlocksPerMultiprocessor(&per_cu, (const void*)fwd_megakernel, NTHR, LDS_BYTES);
        if (per_cu < 1) { fprintf(stderr, "kernel_launch: occupancy query says %d blocks per CU\n", per_cu); per_cu = 1; }
        (void)hipGetLastError();
        grid_blocks = cus * per_cu;
    }
    if (grid_blocks < 0) return;
    Params p{};
    const float** pp = (const float**)&p;
    for (int i = 0; i < 23; ++i) pp[i] = (const float*)d_in[i];
    p.out = (float*)d_out; p.ws = (unsigned char*)d_ws;
    void* args[] = {&p};
    hipError_t e = hipLaunchCooperativeKernel((const void*)fwd_megakernel, dim3(grid_blocks), dim3(NTHR), args, LDS_BYTES, stream);
    if (e != hipSuccess) fprintf(stderr, "cooperative launch failed: %s (grid %d)\n", hipGetErrorString(e), grid_blocks);
}
```
